# Optimizing an MI355X kernel written in HIP

```python
import math
import jax, jax.numpy as jnp
from jax import lax
import numpy as np

D_MODEL = 1024
BATCH = 8
SEQ = 2048
DEPTH = 1

D_MIX = D_MODEL
ATTN_WIDTH = D_MIX // 2
CONV_WIDTH = D_MIX - ATTN_WIDTH
DV = 128
N_ATTN_HEADS = ATTN_WIDTH // DV
DK = DV // 2
ROT_DIM = DK // 4
ROPE_THETA = 500000.0
Q_COLS = N_ATTN_HEADS * 2 * DK
K_COLS = N_ATTN_HEADS * 2 * DK
V_COLS = N_ATTN_HEADS * DV
IN_COLS = Q_COLS + K_COLS + V_COLS + 3 * CONV_WIDTH
CONV_K = 3
Q_BLOCK = 128
NORM_EPS = 1e-6
N_GROUPS = 4
EXPERTS_PER_GROUP = 8
N_EXPERTS = N_GROUPS * EXPERTS_PER_GROUP
TOP_K = 2
D_FF_EXPERT = D_MODEL // 2
MOE_BLOCK = 256

kernel_name = "hymba_diffattn_shortconv_hiermoe"


def rms_norm(x, gain, eps=NORM_EPS):
    xf = x.astype(jnp.float32)
    y = xf * lax.rsqrt(jnp.mean(xf * xf, axis=-1, keepdims=True) + eps)
    return (y * gain.astype(jnp.float32)).astype(x.dtype)


def partial_rotary(t, positions):
    half = ROT_DIM // 2
    freqs = ROPE_THETA ** (-jnp.arange(0, ROT_DIM, 2, dtype=jnp.float32) / ROT_DIM)
    ang = positions.astype(jnp.float32)[..., None] * freqs
    cos = jnp.cos(ang)[:, :, None, None, :]
    sin = jnp.sin(ang)[:, :, None, None, :]
    tf = t.astype(jnp.float32)
    t1, t2, rest = tf[..., :half], tf[..., half:ROT_DIM], tf[..., ROT_DIM:]
    out = jnp.concatenate([t1 * cos - t2 * sin, t2 * cos + t1 * sin, rest], axis=-1)
    return out.astype(t.dtype)


def diff_attention(q, k, v, lam, lambda_init, subln_gain):
    bsz, seq = q.shape[0], q.shape[1]
    scale = DK ** -0.5
    outs = []
    for i in range(seq // Q_BLOCK):
        q0 = i * Q_BLOCK
        end = q0 + Q_BLOCK
        qb = q[:, q0:end]
        kb = k[:, :end]
        vb = v[:, :end]
        s = jnp.einsum('bqhmd,bkhmd->bhmqk', qb, kb).astype(jnp.float32) * scale
        mask = jnp.arange(end)[None, :] <= (q0 + jnp.arange(Q_BLOCK))[:, None]
        s = jnp.where(mask, s, -jnp.inf)
        p = jax.nn.softmax(s, axis=-1)
        a = p[:, :, 0] - lam * p[:, :, 1]
        outs.append(jnp.einsum('bhqk,bkhd->bqhd', a.astype(v.dtype), vb))
    o = jnp.concatenate(outs, axis=1)
    o = rms_norm(o, subln_gain) * (1.0 - lambda_init)
    return o.reshape(bsz, seq, N_ATTN_HEADS * DV)


def short_conv(cb, cc, cu, conv_w, out_gain):
    y = cc * cu
    yp = jnp.pad(y, ((0, 0), (CONV_K - 1, 0), (0, 0)))
    seq = y.shape[1]
    z = sum(conv_w[j] * yp[:, j:j + seq] for j in range(CONV_K))
    return rms_norm(cb * z, out_gain)


def hier_moe(h, w_group_router, w_expert_router, w_gate, w_up, w_down):
    bsz, seq, d = h.shape
    xf = h.reshape(-1, d)
    n_tok = xf.shape[0]
    g_logits = (xf @ w_group_router).astype(jnp.float32)
    g_prob = jax.nn.softmax(g_logits, axis=-1)
    g_sel = jnp.argmax(g_logits, axis=-1)
    g_gate = jnp.take_along_axis(g_prob, g_sel[:, None], axis=-1)
    e_logits = jnp.einsum('nd,gde->nge', xf, w_expert_router).astype(jnp.float32)
    e_sel = jnp.take_along_axis(e_logits, g_sel[:, None, None], axis=1)[:, 0]
    top_v, top_i = lax.top_k(e_sel, TOP_K)
    weights = jax.nn.softmax(top_v, axis=-1) * g_gate
    expert_id = g_sel[:, None] * EXPERTS_PER_GROUP + top_i

    n_assign = n_tok * TOP_K
    flat_e = expert_id.reshape(-1)
    flat_w = weights.reshape(-1)
    flat_t = jnp.repeat(jnp.arange(n_tok, dtype=jnp.int32), TOP_K)
    order = jnp.argsort(flat_e)
    se, st, sw = flat_e[order], flat_t[order], flat_w[order]
    counts = jnp.bincount(flat_e, length=N_EXPERTS)
    starts = jnp.cumsum(counts) - counts
    padded = ((counts + MOE_BLOCK - 1) // MOE_BLOCK) * MOE_BLOCK
    pad_ends = jnp.cumsum(padded)
    pad_starts = pad_ends - padded
    dest = pad_starts[se] + (jnp.arange(n_assign) - starts[se])
    n_blocks = -(-n_assign // MOE_BLOCK) + N_EXPERTS
    rows = jnp.zeros((n_blocks * MOE_BLOCK, d), xf.dtype).at[dest].set(xf[st])
    block_start = jnp.arange(n_blocks) * MOE_BLOCK
    block_e = jnp.minimum(jnp.sum(pad_ends[None, :] <= block_start[:, None], axis=1), N_EXPERTS - 1)

    def expert_block(args):
        xb, e = args
        return (jax.nn.silu(xb @ w_gate[e]) * (xb @ w_up[e])) @ w_down[e]

    out_rows = lax.map(expert_block, (rows.reshape(n_blocks, MOE_BLOCK, d), block_e))
    out_rows = out_rows.reshape(n_blocks * MOE_BLOCK, d)
    y_assign = out_rows[dest] * sw[:, None].astype(out_rows.dtype)
    y = jax.ops.segment_sum(y_assign, st, num_segments=n_tok)
    return y.reshape(bsz, seq, d)


def setup_inputs(seed: int = 0) -> dict:
    key = jax.random.key(seed)
    ks = jax.random.split(key, 24)
    f32 = jnp.float32

    def nrm(k, shape, scale):
        return jax.random.normal(k, shape, f32) * scale

    def gain(k, shape):
        return 1.0 + 0.02 * jax.random.normal(k, shape, f32)

    x = jax.random.normal(ks[0], (BATCH, SEQ, D_MODEL), f32)
    offsets = jax.random.randint(ks[1], (BATCH, 1), 0, 1024, dtype=jnp.int32)
    positions = (offsets + jnp.arange(SEQ, dtype=jnp.int32)[None, :]).astype(jnp.int32)
    return {
        "x": x,
        "positions": positions,
        "attn_norm_gain": gain(ks[2], (DEPTH, D_MODEL)),
        "w_in": nrm(ks[3], (DEPTH, D_MODEL, IN_COLS), D_MODEL ** -0.5),
        "q_norm_gain": gain(ks[4], (DEPTH, DK)),
        "k_norm_gain": gain(ks[5], (DEPTH, DK)),
        "lambda_q1": nrm(ks[6], (DEPTH, DK), 0.1),
        "lambda_k1": nrm(ks[7], (DEPTH, DK), 0.1),
        "lambda_q2": nrm(ks[8], (DEPTH, DK), 0.1),
        "lambda_k2": nrm(ks[9], (DEPTH, DK), 0.1),
        "subln_gain": gain(ks[10], (DEPTH, DV)),
        "conv_w": nrm(ks[11], (DEPTH, CONV_K, CONV_WIDTH), CONV_K ** -0.5),
        "conv_out_gain": gain(ks[12], (DEPTH, CONV_WIDTH)),
        "w_out": nrm(ks[13], (DEPTH, D_MIX, D_MODEL), D_MIX ** -0.5),
        "ffn_norm_gain": gain(ks[14], (DEPTH, D_MODEL)),
        "w_group_router": nrm(ks[15], (DEPTH, D_MODEL, N_GROUPS), D_MODEL ** -0.5),
        "w_expert_router": nrm(ks[16], (DEPTH, N_GROUPS, D_MODEL, EXPERTS_PER_GROUP), D_MODEL ** -0.5),
        "w_gate": nrm(ks[17], (DEPTH, N_EXPERTS, D_MODEL, D_FF_EXPERT), D_MODEL ** -0.5),
        "w_up": nrm(ks[18], (DEPTH, N_EXPERTS, D_MODEL, D_FF_EXPERT), D_MODEL ** -0.5),
        "w_down": nrm(ks[19], (DEPTH, N_EXPERTS, D_FF_EXPERT, D_MODEL), D_FF_EXPERT ** -0.5),
    }


def reference(x, positions, attn_norm_gain, w_in, q_norm_gain, k_norm_gain,
              lambda_q1, lambda_k1, lambda_q2, lambda_k2, subln_gain, conv_w,
              conv_out_gain, w_out, ffn_norm_gain, w_group_router, w_expert_router,
              w_gate, w_up, w_down):
    bsz, seq, _ = x.shape
    splits = [Q_COLS, Q_COLS + K_COLS, Q_COLS + K_COLS + V_COLS,
              Q_COLS + K_COLS + V_COLS + CONV_WIDTH,
              Q_COLS + K_COLS + V_COLS + 2 * CONV_WIDTH]
    for l in range(DEPTH):
        lambda_init = 0.8 - 0.6 * math.exp(-0.3 * l)
        hn = rms_norm(x, attn_norm_gain[l])
        proj = hn @ w_in[l]
        q, k, v, cb, cc, cu = jnp.split(proj, splits, axis=-1)
        q = q.reshape(bsz, seq, N_ATTN_HEADS, 2, DK)
        k = k.reshape(bsz, seq, N_ATTN_HEADS, 2, DK)
        v = v.reshape(bsz, seq, N_ATTN_HEADS, DV)
        q = partial_rotary(rms_norm(q, q_norm_gain[l]), positions)
        k = partial_rotary(rms_norm(k, k_norm_gain[l]), positions)
        lam = (jnp.exp(jnp.sum(lambda_q1[l].astype(jnp.float32) * lambda_k1[l].astype(jnp.float32)))
               - jnp.exp(jnp.sum(lambda_q2[l].astype(jnp.float32) * lambda_k2[l].astype(jnp.float32)))
               + lambda_init)
        attn_o = diff_attention(q, k, v, lam, lambda_init, subln_gain[l])
        conv_o = short_conv(cb, cc, cu, conv_w[l], conv_out_gain[l])
        x = x + jnp.concatenate([attn_o, conv_o], axis=-1) @ w_out[l]
        hn2 = rms_norm(x, ffn_norm_gain[l])
        x = x + hier_moe(hn2, w_group_router[l], w_expert_router[l],
                         w_gate[l], w_up[l], w_down[l])
    return x
```

```cpp
#include <hip/hip_runtime.h>
#include <cstdio>
#include <cstdint>
#ifndef MK_N_LAUNCHES
#define MK_N_LAUNCHES 1
#endif
#ifndef SIMPLE_GEMM
#define SIMPLE_GEMM 0
#endif
#ifndef NAIVE_ATTN
#define NAIVE_ATTN 0
#endif
namespace pg8 {
#define PG8_LAS __attribute__((address_space(3)))
typedef unsigned short bf16_t;
typedef short bf16x8 __attribute__((ext_vector_type(8)));
typedef float f32x4 __attribute__((ext_vector_type(4)));
typedef unsigned u32x4 __attribute__((ext_vector_type(4)));
constexpr int BM = 256, BK = 64, HALF = 128, HTB = HALF * BK * 2  , STAGE_BYTES = 8 * HTB, NXCD = 8, WGM = 8;

__host__ __device__ __forceinline__ int lds_byte(int r, int c) { const int st = (r >> 4) * 2 + (c >> 5), rr = r & 15, cc = c & 31, ob = rr * 64 + cc * 2; return st * 1024 + (ob ^ (((ob >> 9) & 1) << 5)); }
__host__ __device__ __forceinline__ void stage_rc(int b, int& R, int& C) { const int st = b / 1024, sb = b % 1024, swz = sb ^ (((sb >> 9) & 1) << 5); R = (st >> 1) * 16 + swz / 64; C = (st & 1) * 32 + (swz % 64) / 2; }
__host__ __device__ __forceinline__ int perm32(int rho) { const int n = rho >> 4, i = rho & 15; return 8 * (i >> 2) + 4 * n + (i & 3); }

struct Unit { int pm, pn; };
struct Gemm { const bf16_t* A; const bf16_t* Bt; int M, N, K; };

struct StaticOrder {
    int nM, nN, nwg, G, c;
    __host__ __device__ void init(int M, int N, int G_, int c_) { nM = M / BM; nN = N / BM; nwg = nM * nN; G = G_; c = c_; }
    __host__ __device__ bool next(int i, Unit& u) const {
        const long L = (long)i * G + c; if (L >= nwg) return false;
        int wgid = (int)L; { const int q = nwg / NXCD, r = nwg % NXCD, xcd = wgid % NXCD, off = wgid / NXCD; wgid = (xcd < r ? xcd * (q + 1) : r * (q + 1) + (xcd - r) * q) + off; }
        const int nig = WGM * nN, gid = wgid / nig, fm = gid * WGM, gsz = (nM - fm) < WGM ? (nM - fm) : WGM;
        u.pm = fm + ((wgid % nig) % gsz); u.pn = (wgid % nig) / gsz; return true;
    }
    __device__ __forceinline__ void a_ready(const Unit&) const {}
    __device__ __forceinline__ void done(const Unit&) const {}
};

__device__ __forceinline__ unsigned cvt_pk_bf16(float lo, float hi) { unsigned r; asm volatile("v_cvt_pk_bf16_f32 %0, %1, %2" : "=v"(r) : "v"(lo), "v"(hi)); return r; }
typedef unsigned u32x4e __attribute__((ext_vector_type(4)));
struct EpiStoreBf16 {
    static constexpr bool PERM = true, AFTER_DRAIN = false;
    bf16_t* O; int ldc;
    __device__ __forceinline__ void operator()(const f32x4 (&acc)[2][2][4][2], const Unit& u, int wr, int wc, int fr, int fq) const {
        const int row0 = u.pm * BM + wr * 64 + fr, col0 = u.pn * BM + wc * 32 + 8 * fq;
#pragma unroll
        for (int ai = 0; ai < 2; ++ai)
#pragma unroll
            for (int m = 0; m < 4; ++m) { bf16_t* rowp = O + (size_t)(row0 + ai * HALF + m * 16) * ldc + col0;
#pragma unroll
                for (int bj = 0; bj < 2; ++bj) { const f32x4 v0 = acc[ai][bj][m][0], v1 = acc[ai][bj][m][1];
                    u32x4 w; w.x = cvt_pk_bf16(v0[0], v0[1]); w.y = cvt_pk_bf16(v0[2], v0[3]); w.z = cvt_pk_bf16(v1[0], v1[1]); w.w = cvt_pk_bf16(v1[2], v1[3]);
                    *(u32x4*)(rowp + bj * HALF) = w; } }
    }
};
struct EpiResidual {
    static constexpr bool PERM = false, AFTER_DRAIN = false;
    const float* X; float* O; int ldc;
    __device__ __forceinline__ void operator()(const f32x4 (&acc)[2][2][4][2], const Unit& u, int wr, int wc, int fr, int fq) const {
        const int row0 = u.pm * BM + wr * 64 + fr, col0 = u.pn * BM + wc * 32 + 4 * fq;
#pragma unroll
        for (int ai = 0; ai < 2; ++ai)
#pragma unroll
            for (int m = 0; m < 4; ++m) { const size_t off = (size_t)(row0 + ai * HALF + m * 16) * ldc + col0;
#pragma unroll
                for (int bj = 0; bj < 2; ++bj)
#pragma unroll
                    for (int n = 0; n < 2; ++n) { const size_t idx = off + bj * HALF + n * 16; *(f32x4*)(O + idx) = *(const f32x4*)(X + idx) + acc[ai][bj][m][n]; } }
    }
};
__device__ __forceinline__ float swiglu1(float g, float u) { return g * u * __builtin_amdgcn_rcpf(1.0f + __builtin_amdgcn_exp2f(g * -1.4426950408889634f)); }
struct EpiSwiglu {
    static constexpr bool PERM = true, AFTER_DRAIN = false;
    bf16_t* O;
    __device__ __forceinline__ void operator()(const f32x4 (&acc)[2][2][4][2], const Unit& u, int wr, int wc, int fr, int fq) const {
        const int row0 = u.pm * BM + wr * 64 + fr, col0 = (u.pn & 3) * HALF + wc * 32 + 8 * fq;
#pragma unroll
        for (int ai = 0; ai < 2; ++ai)
#pragma unroll
            for (int m = 0; m < 4; ++m) { bf16_t* rowp = O + (size_t)(row0 + ai * HALF + m * 16) * 512 + col0;
                const f32x4 g0 = acc[ai][0][m][0], g1 = acc[ai][0][m][1], u0 = acc[ai][1][m][0], u1 = acc[ai][1][m][1];
                u32x4 w; w.x = cvt_pk_bf16(swiglu1(g0[0], u0[0]), swiglu1(g0[1], u0[1])); w.y = cvt_pk_bf16(swiglu1(g0[2], u0[2]), swiglu1(g0[3], u0[3]));
                w.z = cvt_pk_bf16(swiglu1(g1[0], u1[0]), swiglu1(g1[1], u1[1])); w.w = cvt_pk_bf16(swiglu1(g1[2], u1[2]), swiglu1(g1[3], u1[3]));
                *(u32x4*)rowp = w; }
    }
};
struct EpiDown {
    static constexpr bool PERM = true, AFTER_DRAIN = false;
    bf16_t* Y; const int* slot_tok; const float* slot_w;
    __device__ __forceinline__ void operator()(const f32x4 (&acc)[2][2][4][2], const Unit& u, int wr, int wc, int fr, int fq) const {
        const int slot0 = u.pm * BM + wr * 64 + fr, col0 = (u.pn & 3) * BM + wc * 32 + 8 * fq;
#pragma unroll
        for (int ai = 0; ai < 2; ++ai)
#pragma unroll
            for (int m = 0; m < 4; ++m) { const int slot = slot0 + ai * HALF + m * 16; const int tok = slot_tok[slot];
                if (tok >= 0) { const float sw = slot_w[slot]; bf16_t* rowp = Y + (size_t)tok * 1024 + col0;
#pragma unroll
                    for (int bj = 0; bj < 2; ++bj) { const f32x4 v0 = acc[ai][bj][m][0] * sw, v1 = acc[ai][bj][m][1] * sw;
                        u32x4 w; w.x = cvt_pk_bf16(v0[0], v0[1]); w.y = cvt_pk_bf16(v0[2], v0[3]); w.z = cvt_pk_bf16(v1[0], v1[1]); w.w = cvt_pk_bf16(v1[2], v1[3]);
                        *(u32x4*)(rowp + bj * HALF) = w; } } }
    }
};
struct MoeOrder {
    const PG8_LAS int* tile_e; int nU, q, bpx, xcd, r;
    __device__ __forceinline__ void init(const PG8_LAS int* te, int nT, int G, int c) { tile_e = te; nU = 4 * nT; if (G % 8 == 0) { bpx = G / 8; xcd = c & 7; r = c >> 3; q = (nU + 7) / 8; } else { bpx = G; xcd = 0; r = c; q = nU; } }
    __device__ __forceinline__ bool next(int i, Unit& u) const {
        const int s = i * bpx + r; if (s >= q) return false;
        const int L = xcd * q + s; if (L >= nU) return false;
        const int pm = L >> 2; u.pm = pm; u.pn = __builtin_amdgcn_readfirstlane(tile_e[pm]) * 4 + (L & 3); return true;
    }
    __device__ __forceinline__ void a_ready(const Unit&) const {}
    __device__ __forceinline__ void done(const Unit&) const {}
};
template <class Epi, class Sched>
__device__ __forceinline__ void simple_gemm_phase(const Gemm g, const Sched& S, const Epi& E) {
    const int tid = threadIdx.x, wid = __builtin_amdgcn_readfirstlane(tid >> 6), lane = tid & 63, wr = wid >> 2, wc = wid & 3, fr = lane & 15, fq = lane >> 4;
    Unit u;
    for (int i = 0; S.next(i, u); ++i) {
        f32x4 acc[2][2][4][2];
#pragma unroll
        for (int a = 0; a < 2; ++a)
#pragma unroll
            for (int b = 0; b < 2; ++b)
#pragma unroll
                for (int m = 0; m < 4; ++m)
#pragma unroll
                    for (int n = 0; n < 2; ++n) acc[a][b][m][n] = (f32x4){0.f, 0.f, 0.f, 0.f};
        const bf16_t* Ab = g.A + (size_t)(u.pm * BM + wr * 64 + fr) * g.K + fq * 8;
        const int brow = Epi::PERM ? (wc * 32 + 8 * (fr >> 2) + (fr & 3)) : (wc * 32 + fr);
        const bf16_t* Bb = g.Bt + (size_t)(u.pn * BM + brow) * g.K + fq * 8;
        for (int k0 = 0; k0 < g.K; k0 += 32) {
            bf16x8 a[2][4], b[2][2];
#pragma unroll
            for (int ai = 0; ai < 2; ++ai)
#pragma unroll
                for (int m = 0; m < 4; ++m) a[ai][m] = *(const bf16x8*)(Ab + (size_t)(ai * HALF + m * 16) * g.K + k0);
#pragma unroll
            for (int bj = 0; bj < 2; ++bj)
#pragma unroll
                for (int n = 0; n < 2; ++n) b[bj][n] = *(const bf16x8*)(Bb + (size_t)(bj * HALF + (Epi::PERM ? 4 * n : 16 * n)) * g.K + k0);
#pragma unroll
            for (int ai = 0; ai < 2; ++ai)
#pragma unroll
                for (int bj = 0; bj < 2; ++bj)
#pragma unroll
                    for (int m = 0; m < 4; ++m)
#pragma unroll
                        for (int n = 0; n < 2; ++n) acc[ai][bj][m][n] = __builtin_amdgcn_mfma_f32_16x16x32_bf16(b[bj][n], a[ai][m], acc[ai][bj][m][n], 0, 0, 0);
        }
        E(acc, u, wr, wc, fr, fq);
    }
}
template <class Epi, class Sched, bool ALIGN_EPI = false, bool SP2 = false>
__device__ __forceinline__ void gemm_phase(PG8_LAS unsigned char* lds, const Gemm g, const Sched& S, const Epi& E) {
    const int tid = threadIdx.x, wid = __builtin_amdgcn_readfirstlane(tid >> 6), lane = tid & 63, wr = wid >> 2, wc = wid & 3, fr = lane & 15, fq = lane >> 4;
    const int K = g.K, nt = K / BK;
    unsigned voffA[2], voffB[2];
#pragma unroll
    for (int i = 0; i < 2; ++i) { int R, C; stage_rc(tid * 16 + i * 8192, R, C); const int Rb = Epi::PERM ? ((R & ~31) + perm32(R & 31)) : R;
        voffA[i] = (unsigned)(R * K + C) * 2u; voffB[i] = (unsigned)(Rb * K + C) * 2u; }
    const size_t kstep = (size_t)(BK * 2);
    const size_t hstep = (size_t)HALF * K * 2;
    const size_t tstep = 2 * hstep;
    const unsigned ldsw = (unsigned)wid * 1024u;
    const int aoff = lds_byte(wr * 64 + fr, fq * 8), boff = lds_byte(wc * 32 + fr, fq * 8);
#define PG8_SA(b, h) (((b) * 2 + (h)) * HTB)
#define PG8_SB(b, h) ((4 + (b) * 2 + (h)) * HTB)
#define PG8_STAGE(bufoff, gbase, voff) do { _Pragma("unroll") for (int _i = 0; _i < 2; ++_i) \
        __builtin_amdgcn_global_load_lds((const unsigned*)((const char*)(gbase) + (voff)[_i]), (PG8_LAS unsigned*)(lds + (bufoff) + ldsw + _i * 8192), 16, 0, 0); } while (0)
#define PG8_LDA(dst, b, h) do { _Pragma("unroll") for (int m = 0; m < 4; ++m) _Pragma("unroll") for (int k = 0; k < 2; ++k) dst[m][k] = *(const PG8_LAS bf16x8*)(lds + PG8_SA(b, h) + aoff + m * 2048 + k * 1024); } while (0)
#define PG8_LDB(dst, b, h) do { _Pragma("unroll") for (int n = 0; n < 2; ++n) _Pragma("unroll") for (int k = 0; k < 2; ++k) dst[n][k] = *(const PG8_LAS bf16x8*)(lds + PG8_SB(b, h) + boff + n * 2048 + k * 1024); } while (0)
#define PG8_MMA(ai, bj, At, Bt) do { __builtin_amdgcn_s_setprio(1); _Pragma("unroll") for (int m = 0; m < 4; ++m) _Pragma("unroll") for (int n = 0; n < 2; ++n) _Pragma("unroll") for (int k = 0; k < 2; ++k) \
        acc[ai][bj][m][n] = __builtin_amdgcn_mfma_f32_16x16x32_bf16(Bt[n][k], At[m][k], acc[ai][bj][m][n], 0, 0, 0); __builtin_amdgcn_s_setprio(0); } while (0)
#define PG8_WAIT_V(n) asm volatile("s_waitcnt vmcnt(" #n ")" ::: "memory")
#define PG8_WAIT_L(n) asm volatile("s_waitcnt lgkmcnt(" #n ")" ::: "memory")
#define PG8_BAR __builtin_amdgcn_s_barrier()
#define PG8_SCHED __builtin_amdgcn_sched_barrier(0)
    Unit cur, nxt; int ui = 0;
    if (!S.next(0, cur)) return;
    f32x4 acc[2][2][4][2];
#pragma unroll
    for (int a = 0; a < 2; ++a)
#pragma unroll
        for (int b = 0; b < 2; ++b)
#pragma unroll
            for (int m = 0; m < 4; ++m)
#pragma unroll
                for (int n = 0; n < 2; ++n) acc[a][b][m][n] = (f32x4){0.f, 0.f, 0.f, 0.f};
    bf16x8 At[4][2], B0[2][2], B1[2][2];
    const char* cA = (const char*)g.A + (size_t)cur.pm * tstep; const char* cB = (const char*)g.Bt + (size_t)cur.pn * tstep;
    S.a_ready(cur);
    if constexpr (SP2) {
        PG8_STAGE(PG8_SB(0, 0), cB, voffB); PG8_STAGE(PG8_SB(0, 1), cB + hstep, voffB); PG8_STAGE(PG8_SA(0, 0), cA, voffA); PG8_STAGE(PG8_SA(0, 1), cA + hstep, voffA);
        if (wr == 1) PG8_BAR;
        PG8_WAIT_V(2); PG8_BAR;
        PG8_STAGE(PG8_SB(1, 0), cB + kstep, voffB); PG8_STAGE(PG8_SA(1, 0), cA + kstep, voffA); PG8_STAGE(PG8_SB(1, 1), cB + hstep + kstep, voffB);
        PG8_WAIT_V(6); PG8_BAR;
    } else {
        PG8_STAGE(PG8_SB(0, 0), cB, voffB); PG8_STAGE(PG8_SA(0, 0), cA, voffA); PG8_STAGE(PG8_SB(0, 1), cB + hstep, voffB); PG8_STAGE(PG8_SA(0, 1), cA + hstep, voffA);
        if (wr == 1) PG8_BAR;
        PG8_WAIT_V(4); PG8_BAR;
        PG8_STAGE(PG8_SB(1, 0), cB + kstep, voffB); PG8_STAGE(PG8_SA(1, 0), cA + kstep, voffA); PG8_STAGE(PG8_SB(1, 1), cB + hstep + kstep, voffB);
        PG8_WAIT_V(6); PG8_BAR;
    }
    for (;;) {
        const bool has_next = S.next(ui + 1, nxt);
        const char* nA = has_next ? (const char*)g.A + (size_t)nxt.pm * tstep : cA; const char* nB = has_next ? (const char*)g.Bt + (size_t)nxt.pn * tstep : cB;
        for (int t = 0; t < nt; t += 2) {
            const bool last = (t == nt - 2);
            const char* a1 = cA + (size_t)(t + 1) * kstep;
            const char* a2 = last ? nA : cA + (size_t)(t + 2) * kstep; const char* b2 = last ? nB : cB + (size_t)(t + 2) * kstep;
            const char* a3 = a2 + kstep; const char* b3 = b2 + kstep;
            if (last && has_next) S.a_ready(nxt);
            if constexpr (SP2) {
            PG8_LDB(B0, 0, 0); PG8_LDB(B1, 0, 1); PG8_SCHED; PG8_LDA(At, 0, 0); PG8_STAGE(PG8_SA(1, 1), a1 + hstep, voffA);
            PG8_WAIT_V(8); PG8_WAIT_L(0); PG8_BAR; PG8_MMA(0, 0, At, B0); PG8_MMA(0, 1, At, B1); PG8_BAR; PG8_SCHED;
            PG8_LDA(At, 0, 1); PG8_STAGE(PG8_SB(0, 0), b2, voffB); PG8_STAGE(PG8_SB(0, 1), b2 + hstep, voffB); PG8_STAGE(PG8_SA(0, 0), a2, voffA);
            PG8_WAIT_V(8); PG8_WAIT_L(0); PG8_BAR; PG8_MMA(1, 0, At, B0); PG8_MMA(1, 1, At, B1); PG8_BAR; PG8_SCHED;
            PG8_LDB(B0, 1, 0); PG8_LDB(B1, 1, 1); PG8_SCHED; PG8_LDA(At, 1, 0); PG8_STAGE(PG8_SA(0, 1), a2 + hstep, voffA);
            PG8_WAIT_V(8); PG8_WAIT_L(0); PG8_BAR; PG8_MMA(0, 0, At, B0); PG8_MMA(0, 1, At, B1); PG8_BAR; PG8_SCHED;
            PG8_LDA(At, 1, 1); PG8_STAGE(PG8_SB(1, 0), b3, voffB); PG8_STAGE(PG8_SB(1, 1), b3 + hstep, voffB); PG8_STAGE(PG8_SA(1, 0), a3, voffA);
            PG8_WAIT_V(8); PG8_WAIT_L(0); PG8_BAR; PG8_MMA(1, 0, At, B0); PG8_MMA(1, 1, At, B1); PG8_BAR; PG8_SCHED;
            } else {
            PG8_LDB(B0, 0, 0); PG8_SCHED; PG8_LDA(At, 0, 0); PG8_STAGE(PG8_SA(1, 1), a1 + hstep, voffA);
            PG8_WAIT_L(8); PG8_BAR; PG8_WAIT_L(0); PG8_MMA(0, 0, At, B0); PG8_BAR; PG8_SCHED;
            PG8_LDB(B1, 0, 1); PG8_STAGE(PG8_SB(0, 0), b2, voffB);
            PG8_BAR; PG8_WAIT_L(0); PG8_MMA(0, 1, At, B1); PG8_BAR;
            PG8_LDA(At, 0, 1); PG8_STAGE(PG8_SA(0, 0), a2, voffA);
            PG8_BAR; PG8_WAIT_L(0); PG8_MMA(1, 0, At, B0); PG8_BAR; PG8_SCHED;
            PG8_STAGE(PG8_SB(0, 1), b2 + hstep, voffB);
            PG8_WAIT_V(6); PG8_BAR; PG8_MMA(1, 1, At, B1); PG8_BAR;
            PG8_LDB(B0, 1, 0); PG8_SCHED; PG8_LDA(At, 1, 0); PG8_STAGE(PG8_SA(0, 1), a2 + hstep, voffA);
            PG8_WAIT_L(8); PG8_BAR; PG8_WAIT_L(0); PG8_MMA(0, 0, At, B0); PG8_BAR; PG8_SCHED;
            PG8_LDB(B1, 1, 1); PG8_STAGE(PG8_SB(1, 0), b3, voffB);
            PG8_BAR; PG8_WAIT_L(0); PG8_MMA(0, 1, At, B1); PG8_BAR;
            PG8_LDA(At, 1, 1); PG8_STAGE(PG8_SA(1, 0), a3, voffA);
            PG8_BAR; PG8_WAIT_L(0); PG8_MMA(1, 0, At, B0); PG8_BAR; PG8_SCHED;
            PG8_STAGE(PG8_SB(1, 1), b3 + hstep, voffB);
            PG8_WAIT_V(6); PG8_BAR; PG8_MMA(1, 1, At, B1); PG8_BAR;
            }
        }
        if constexpr (ALIGN_EPI) { if (wr == 0) PG8_BAR; }
        if constexpr (!Epi::AFTER_DRAIN) { E(acc, cur, wr, wc, fr, fq); S.done(cur); }
        if (!has_next) break;
#pragma unroll
        for (int a = 0; a < 2; ++a)
#pragma unroll
            for (int b = 0; b < 2; ++b)
#pragma unroll
                for (int m = 0; m < 4; ++m)
#pragma unroll
                    for (int n = 0; n < 2; ++n) acc[a][b][m][n] = (f32x4){0.f, 0.f, 0.f, 0.f};
        cur = nxt; cA = nA; cB = nB; ++ui;
        if constexpr (ALIGN_EPI) { if (wr == 1) PG8_BAR; }
    }
    PG8_WAIT_V(0);
    if constexpr (!ALIGN_EPI) { if (wr == 0) PG8_BAR; }
    PG8_BAR;
    if constexpr (Epi::AFTER_DRAIN) { E.fused(acc, cur, wr, wc, fr, fq, lds, wid, lane); S.done(cur); }
#undef PG8_SA
#undef PG8_SB
#undef PG8_STAGE
#undef PG8_LDA
#undef PG8_LDB
#undef PG8_MMA
#undef PG8_WAIT_V
#undef PG8_WAIT_L
#undef PG8_BAR
#undef PG8_SCHED
}
}
constexpr int NWAVES = 8;
constexpr int N_LAUNCHES = MK_N_LAUNCHES;
constexpr int PER_PHASE = 10;
constexpr int NTOK = 16384, DM = 1024, SEQ = 2048, NBATCH = 8, NHEAD = 4;
constexpr int INC = 3072;
constexpr int KOFF = 512, VOFF = 1024, CBOFF = 1536, CCOFF = 2048, CUOFF = 2560;
constexpr int NE = 32, DFF = 512, MAXT = 160, MAXSLOT = MAXT * 256;
constexpr float NORM_EPS = 1e-6f;
constexpr float QSCALE = 0.125f * 1.4426950408889634f;
constexpr float LAMBDA_INIT = 0.2f;
constexpr size_t MiB = 1u << 20;
constexpr size_t WS_CTL = 0, CTL_ZERO_BYTES = 65536;
constexpr size_t WS_WIN = 1 * MiB, WS_WOUT = 7 * MiB, WS_WGU = 9 * MiB, WS_WD = 73 * MiB;
constexpr size_t WS_PROJ = 105 * MiB;
constexpr size_t WS_XG = 105 * MiB;
constexpr size_t WS_Y2 = 105 * MiB;
constexpr size_t WS_ACT = 185 * MiB;
constexpr size_t WS_MIX = 201 * MiB;
constexpr size_t WS_HN2 = 201 * MiB;
constexpr size_t WS_SMALL = 233 * MiB;
constexpr size_t SM_TOKE = 0, SM_TOKW = 131072, SM_SLOTT = 262144, SM_SLOTW = 262144 + 163840, SM_CCNT = 262144 + 2 * 163840, SM_TTAB = SM_CCNT + 32768;
constexpr size_t WS_END = 234 * MiB;
static_assert(WS_XG + (size_t)MAXSLOT * 1024 * 2 <= WS_ACT && WS_ACT + (size_t)MAXSLOT * 512 * 2 <= WS_SMALL && WS_PROJ + (size_t)NTOK * INC * 2 <= WS_MIX && SM_TTAB + 1024 <= MiB, "d_ws map");
constexpr int CW_TMO = 0, CW_BAR = 4096;
constexpr int RING_OFF = 0, RING_BYTES = 131072;
constexpr int TAB_OFF = RING_BYTES;
constexpr int LDSCTL_OFF = RING_BYTES + 1024, MISC_OFF = LDSCTL_OFF + 320;
constexpr int LDS_BYTES = 147456;
static_assert(MISC_OFF + 128 <= LDS_BYTES, "LDS map");
#define GAS __attribute__((address_space(1)))
#define LAS __attribute__((address_space(3)))
typedef unsigned short bf16;
typedef unsigned v4u __attribute__((ext_vector_type(4)));
typedef float f32x4 __attribute__((ext_vector_type(4)));
typedef short bf16x8 __attribute__((ext_vector_type(8)));
typedef GAS unsigned gu32;
typedef GAS unsigned long long gu64;
#define RLX_AGENT __ATOMIC_RELAXED, __HIP_MEMORY_SCOPE_AGENT
#define LDS_WAIT() asm volatile("s_waitcnt lgkmcnt(0)" ::: "memory")
#define VM_WAIT() asm volatile("s_waitcnt vmcnt(0)" ::: "memory")
__device__ __forceinline__ unsigned long long rt() { return __builtin_amdgcn_s_memrealtime(); }
__device__ __forceinline__ unsigned f2bf(float f) { unsigned u = __builtin_bit_cast(unsigned, f); return (u + 0x7fffu + ((u >> 16) & 1u)) >> 16; }
__device__ __forceinline__ unsigned pk2(float lo, float hi) { return f2bf(lo) | (f2bf(hi) << 16); }

#define XB_TMO      128
#define XB_XCNT(j)  (256  + 64 * (j))
#define XB_XSUB(j)  (1280 + 64 * (j))
#define XB_XGEN(j)  (2304 + 64 * (j))
#define XB_TOP      3328
#define XB_TOPGEN   3392
#define XCD_BAR_WORDS 3456
#define XB_SPIN_CAP (1u << 18)

__device__ __forceinline__ unsigned xb_ld(unsigned* p)              { return __hip_atomic_load(p, __ATOMIC_RELAXED, __HIP_MEMORY_SCOPE_AGENT); }
__device__ __forceinline__ unsigned xb_add(unsigned* p, unsigned v) { return __hip_atomic_fetch_add(p, v, __ATOMIC_RELAXED, __HIP_MEMORY_SCOPE_AGENT); }
__device__ __forceinline__ unsigned xb_xcc_id() { return (unsigned)__builtin_amdgcn_s_getreg((3 << 11) | 20) & 0xFu; }
#define XB_SPIN(cond, bar) do { unsigned _sp = 0; while (cond) { __builtin_amdgcn_s_sleep(1); \
    if ((++_sp & 255u) == 0u) { if (xb_ld(&(bar)[XB_TMO])) break; if (_sp > XB_SPIN_CAP) { atomicAdd(&(bar)[XB_TMO], 1u); break; } } } } while (0)

struct XcdBarrier {
    unsigned* bar; unsigned x;
    volatile LAS unsigned* st;
};

__device__ __forceinline__ XcdBarrier xcd_barrier_post(unsigned* bar, volatile LAS unsigned* st) {
    XcdBarrier b; b.bar = bar; b.x = xb_xcc_id(); b.st = st;
    if (threadIdx.x == 0) (void)xb_add(&bar[XB_XCNT(b.x)], 1u);
    return b;
}
__device__ __forceinline__ void xcd_barrier_complete(unsigned* bar, unsigned x, unsigned& nloc, unsigned& nx) {
    const unsigned G = gridDim.x * gridDim.y * gridDim.z;
    unsigned sum, cnt, mine, sp = 0u;
    for (;;) {
        sum = 0u; cnt = 0u; mine = 0u;
#pragma unroll
        for (unsigned j = 0; j < 16; ++j) { const unsigned c = xb_ld(&bar[XB_XCNT(j)]); sum += c; cnt += (c > 0u) ? 1u : 0u; mine = (j == x) ? c : mine; }
        if (sum == G) break;
        __builtin_amdgcn_s_sleep(1);
        if ((++sp & 255u) == 0u) { if (xb_ld(&bar[XB_TMO])) break; if (sp > XB_SPIN_CAP) { atomicAdd(&bar[XB_TMO], 1u); break; } }
    }
    nloc = mine > 0u ? mine : 1u; nx = cnt > 0u ? cnt : 1u;
}

__device__ __forceinline__ void xcd_barrier(const XcdBarrier& b) {
    asm volatile("s_waitcnt vmcnt(0)" ::: "memory");
    __syncthreads();
    if (threadIdx.x == 0) {
        unsigned* bar = b.bar;
        __builtin_amdgcn_s_waitcnt(0);
        unsigned nloc = b.st[0], nx = b.st[1];
        if (nloc == 0u) { xcd_barrier_complete(bar, b.x, nloc, nx); b.st[0] = nloc; b.st[1] = nx; }
        const unsigned old = xb_add(&bar[XB_XSUB(b.x)], 1u);
        const unsigned gen = old / nloc;
        if (old + 1u == (gen + 1u) * nloc) {
            __builtin_amdgcn_fence(__ATOMIC_RELEASE, "agent");
            asm volatile("s_waitcnt vmcnt(0)" ::: "memory");
            const unsigned og = xb_add(&bar[XB_TOP], 1u);
            const unsigned tg = og / nx;
            if (og + 1u == (tg + 1u) * nx) xb_add(&bar[XB_TOPGEN], 1u);
            else XB_SPIN(xb_ld(&bar[XB_TOPGEN]) == tg, bar);
            __builtin_amdgcn_fence(__ATOMIC_ACQUIRE, "agent");
            xb_add(&bar[XB_XGEN(b.x)], 1u);
            asm volatile("s_waitcnt vmcnt(0)" ::: "memory");
        } else {
            XB_SPIN(xb_ld(&bar[XB_XGEN(b.x)]) == gen, bar);
            __builtin_amdgcn_fence(__ATOMIC_ACQUIRE, "agent");
            asm volatile("s_waitcnt vmcnt(0)" ::: "memory");
        }
    }
    __syncthreads();
}
typedef short s16x4 __attribute__((ext_vector_type(4)));
typedef float f32x16 __attribute__((ext_vector_type(16)));
typedef unsigned v2u __attribute__((ext_vector_type(2)));
struct Frame {
    LAS unsigned char* lds;
    volatile LAS unsigned* MISC;
    gu32* ctl;
    int tid, lane, wave;
    int vcu, G;
    const float* x; const int* pos; const float *g_attn, *w_in, *g_q, *g_k, *lq1, *lk1, *lq2, *lk2, *g_sub, *conv_w, *g_conv, *w_out, *g_ffn, *w_gr, *w_er, *w_gate, *w_up, *w_down;
    float* out;
    bf16 *Wt_in, *Wt_out, *Wt_gu, *Wt_d;
    bf16 *HN, *PROJ, *MIX, *HN2, *XG, *ACT, *Y2;
    int* tok_e; float* tok_w; int* slot_tok; float* slot_w; int* ccnt; int* ttab;
};
__device__ __forceinline__ float wave_sum(float v) {
#pragma unroll
    for (int o = 1; o < 64; o <<= 1) v += __shfl_xor(v, o);
    return v;
}
__device__ __forceinline__ float wave_max(float v) {
#pragma unroll
    for (int o = 1; o < 64; o <<= 1) v = fmaxf(v, __shfl_xor(v, o));
    return v;
}
__device__ __forceinline__ float bf2f(unsigned short b) { return __builtin_bit_cast(float, (unsigned)b << 16); }
__device__ __forceinline__ float bflo(unsigned w) { return __builtin_bit_cast(float, w << 16); }
__device__ __forceinline__ float bfhi(unsigned w) { return __builtin_bit_cast(float, w & 0xffff0000u); }

__device__ __forceinline__ void p0_transpose_item(const float* W, int K, int N, bf16* WT, int k0, int n0, int dst_row0, LAS float* scr, int lane) {
#pragma unroll 8
    for (int i = 0; i < 32; ++i) { const int kk = 2 * i + (lane >> 5); scr[kk * 33 + (lane & 31)] = W[(size_t)(k0 + kk) * N + n0 + (lane & 31)]; }
    LDS_WAIT(); asm volatile("" ::: "memory");
    const int c = lane & 7;
#pragma unroll
    for (int j = 0; j < 4; ++j) { const int n = (lane >> 3) + 8 * j; const LAS float* s = scr + (8 * c) * 33 + n;
        v4u o; o.x = pk2(s[0 * 33], s[1 * 33]); o.y = pk2(s[2 * 33], s[3 * 33]); o.z = pk2(s[4 * 33], s[5 * 33]); o.w = pk2(s[6 * 33], s[7 * 33]);
        *(GAS v4u*)(WT + (size_t)(dst_row0 + n) * K + k0 + 8 * c) = o; }
    LDS_WAIT(); asm volatile("" ::: "memory");
}
__device__ __forceinline__ void rms_row_to_bf16(const float* xrow, const float* gain, bf16* orow, int lane) {
    const GAS f32x4* xr = (const GAS f32x4*)xrow + lane; const GAS f32x4* gr = (const GAS f32x4*)gain + lane;
    f32x4 v[4]; float s = 0.f;
#pragma unroll
    for (int j = 0; j < 4; ++j) { v[j] = xr[64 * j]; s += (v[j].x * v[j].x + v[j].y * v[j].y) + (v[j].z * v[j].z + v[j].w * v[j].w); }
    const float rstd = 1.f / sqrtf(wave_sum(s) * (1.f / DM) + NORM_EPS);
    GAS unsigned long long* o8 = (GAS unsigned long long*)orow + lane;
#pragma unroll
    for (int j = 0; j < 4; ++j) { const f32x4 g = gr[64 * j]; o8[64 * j] = (unsigned long long)pk2(v[j].x * rstd * g.x, v[j].y * rstd * g.y) | ((unsigned long long)pk2(v[j].z * rstd * g.z, v[j].w * rstd * g.w) << 32); }
}
__device__ __forceinline__ void p0_prologue(Frame& F) {
    LAS float* scr = (LAS float*)(F.lds + RING_OFF + F.wave * 16384);
    const int gw = F.vcu * NWAVES + F.wave, NGW = F.G * NWAVES;
    constexpr int I_IN = (DM / 64) * (INC / 32), I_OUT = (DM / 64) * (DM / 32), I_G = (DM / 64) * (DFF / 32), I_D = (DFF / 64) * (DM / 32);
    constexpr int NITEMS = I_IN + I_OUT + NE * (2 * I_G + I_D);
    for (int it = gw; it < NITEMS; it += NGW) {
        int r = it;
        if (r < I_IN) { const int kb = r / (INC / 32), nb = r % (INC / 32); p0_transpose_item(F.w_in, DM, INC, F.Wt_in, 64 * kb, 32 * nb, 32 * nb, scr, F.lane); continue; } r -= I_IN;
        if (r < I_OUT) { const int kb = r / (DM / 32), nb = r % (DM / 32); p0_transpose_item(F.w_out, DM, DM, F.Wt_out, 64 * kb, 32 * nb, 32 * nb, scr, F.lane); continue; } r -= I_OUT;
        const int e = r / (2 * I_G + I_D); r -= e * (2 * I_G + I_D);
        if (r < 2 * I_G) { const int up = r >= I_G; if (up) r -= I_G; const int kb = r / (DFF / 32), nb = r % (DFF / 32), n0 = 32 * nb;
            p0_transpose_item((up ? F.w_up : F.w_gate) + (size_t)e * DM * DFF, DM, DFF, F.Wt_gu, 64 * kb, n0, e * 1024 + (n0 >> 7) * 256 + up * 128 + (n0 & 127), scr, F.lane); continue; }
        r -= 2 * I_G;
        { const int kb = r / (DM / 32), nb = r % (DM / 32); p0_transpose_item(F.w_down + (size_t)e * DFF * DM, DFF, DM, F.Wt_d, 64 * kb, 32 * nb, e * 1024 + 32 * nb, scr, F.lane); }
    }
    for (int m = gw; m < NTOK; m += NGW) rms_row_to_bf16(F.x + (size_t)m * DM, F.g_attn, F.HN + (size_t)m * DM, F.lane);
    for (int i = gw * 64 + F.lane; i < MAXSLOT; i += NGW * 64) F.slot_tok[i] = -1;
}

__device__ __forceinline__ void p2_qk_conv(Frame& F) {
    const int gw = F.vcu * NWAVES + F.wave, NGW = F.G * NWAVES, lane = F.lane;
    const int sub = lane & 7;
    float gq[8], gk[8];
#pragma unroll
    for (int j = 0; j < 8; ++j) { gq[j] = F.g_q[sub * 8 + j] * QSCALE; gk[j] = F.g_k[sub * 8 + j]; }
    float cw0[8], cw1[8], cw2[8], gc[8];
#pragma unroll
    for (int j = 0; j < 8; ++j) { cw0[j] = F.conv_w[lane * 8 + j]; cw1[j] = F.conv_w[512 + lane * 8 + j]; cw2[j] = F.conv_w[1024 + lane * 8 + j]; gc[j] = F.g_conv[lane * 8 + j]; }
    for (int t = gw; t < NTOK; t += NGW) {
        bf16* row = F.PROJ + (size_t)t * INC;
        const float posf = (float)F.pos[t];
        float cs[8], sn[8];
#pragma unroll
        for (int i = 0; i < 8; ++i) { const float fr = exp2f(-(float)i * (18.931568569324174f / 8.0f)); const float ang = posf * fr;
            const float rev = __builtin_amdgcn_fractf(ang * 0.15915494309189535f); cs[i] = __builtin_amdgcn_cosf(rev); sn[i] = __builtin_amdgcn_sinf(rev); }
#pragma unroll
        for (int which = 0; which < 2; ++which) {
            GAS v4u* p = (GAS v4u*)(row + which * KOFF) + lane;
            const v4u w = *p; float v[8];
            v[0] = bflo(w.x); v[1] = bfhi(w.x); v[2] = bflo(w.y); v[3] = bfhi(w.y); v[4] = bflo(w.z); v[5] = bfhi(w.z); v[6] = bflo(w.w); v[7] = bfhi(w.w);
            float ss = 0.f;
#pragma unroll
            for (int j = 0; j < 8; ++j) ss += v[j] * v[j];
            ss += __shfl_xor(ss, 1); ss += __shfl_xor(ss, 2); ss += __shfl_xor(ss, 4);
            const float rstd = 1.f / sqrtf(ss * (1.f / 64.f) + NORM_EPS);
#pragma unroll
            for (int j = 0; j < 8; ++j) v[j] = v[j] * rstd * (which ? gk[j] : gq[j]);
            float o[8];
#pragma unroll
            for (int j = 0; j < 8; ++j) { const float other = __shfl_xor(v[j], 1);
                o[j] = (sub == 0) ? (v[j] * cs[j] - other * sn[j]) : ((sub == 1) ? (v[j] * cs[j] + other * sn[j]) : v[j]); }
            v4u r; r.x = pk2(o[0], o[1]); r.y = pk2(o[2], o[3]); r.z = pk2(o[4], o[5]); r.w = pk2(o[6], o[7]);
            *p = r;
        }
        {
            const int ts = t & (SEQ - 1);
            float z[8];
#pragma unroll
            for (int j = 0; j < 8; ++j) z[j] = 0.f;
#pragma unroll
            for (int d = 0; d < 3; ++d) {
                if (ts - d >= 0) {
                    const bf16* rr = row - (size_t)d * INC;
                    const v4u c = *((const GAS v4u*)(rr + CCOFF) + lane), u = *((const GAS v4u*)(rr + CUOFF) + lane);
                    float y[8];
                    y[0] = bflo(c.x) * bflo(u.x); y[1] = bfhi(c.x) * bfhi(u.x); y[2] = bflo(c.y) * bflo(u.y); y[3] = bfhi(c.y) * bfhi(u.y);
                    y[4] = bflo(c.z) * bflo(u.z); y[5] = bfhi(c.z) * bfhi(u.z); y[6] = bflo(c.w) * bflo(u.w); y[7] = bfhi(c.w) * bfhi(u.w);
#pragma unroll
                    for (int j = 0; j < 8; ++j) z[j] += (d == 0 ? cw2[j] : (d == 1 ? cw1[j] : cw0[j])) * y[j];
                }
            }
            const v4u b = *((const GAS v4u*)(row + CBOFF) + lane);
            float v[8];
            v[0] = bflo(b.x) * z[0]; v[1] = bfhi(b.x) * z[1]; v[2] = bflo(b.y) * z[2]; v[3] = bfhi(b.y) * z[3];
            v[4] = bflo(b.z) * z[4]; v[5] = bfhi(b.z) * z[5]; v[6] = bflo(b.w) * z[6]; v[7] = bfhi(b.w) * z[7];
            float ss = 0.f;
#pragma unroll
            for (int j = 0; j < 8; ++j) ss += v[j] * v[j];
            const float rstd = 1.f / sqrtf(wave_sum(ss) * (1.f / 512.f) + NORM_EPS);
            v4u r; r.x = pk2(v[0] * rstd * gc[0], v[1] * rstd * gc[1]); r.y = pk2(v[2] * rstd * gc[2], v[3] * rstd * gc[3]);
            r.z = pk2(v[4] * rstd * gc[4], v[5] * rstd * gc[5]); r.w = pk2(v[6] * rstd * gc[6], v[7] * rstd * gc[7]);
            *((GAS v4u*)(F.MIX + (size_t)t * DM + 512) + lane) = r;
        }
    }
}
__device__ __forceinline__ float lambda_full(const Frame& F) {
    const int l = F.lane; const float a = wave_sum(F.lq1[l] * F.lk1[l]), b = wave_sum(F.lq2[l] * F.lk2[l]);
    return expf(a) - expf(b) + LAMBDA_INIT;
}
#if NAIVE_ATTN
#define NAIVE_DOT(kr, s0, s1) do { _Pragma("unroll") for (int c_ = 0; c_ < 16; ++c_) { const v4u w_ = *((const GAS v4u*)(kr) + c_); const LAS float* q_ = qs + 8 * c_; \
    const float d_ = q_[0] * bflo(w_.x) + q_[1] * bfhi(w_.x) + q_[2] * bflo(w_.y) + q_[3] * bfhi(w_.y) + q_[4] * bflo(w_.z) + q_[5] * bfhi(w_.z) + q_[6] * bflo(w_.w) + q_[7] * bfhi(w_.w); \
    if (c_ < 8) s0 += d_; else s1 += d_; } } while (0)
__device__ __forceinline__ void p3_attention(Frame& F) {
    const int gw = F.vcu * NWAVES + F.wave, NGW = F.G * NWAVES, lane = F.lane;
    const float lam = lambda_full(F);
    LAS float* qs = (LAS float*)(F.lds + RING_OFF) + F.wave * 256;
    LAS float* af = qs + 128;
    for (int R = gw; R < NBATCH * NHEAD * SEQ; R += NGW) {
        const int bh = R / SEQ, q = R % SEQ, b = bh / NHEAD, h = bh % NHEAD;
        const bf16* base = F.PROJ + (size_t)b * SEQ * INC + h * 128;
        qs[lane] = bf2f(base[(size_t)q * INC + lane]); qs[64 + lane] = bf2f(base[(size_t)q * INC + 64 + lane]);
        LDS_WAIT(); asm volatile("" ::: "memory");
        float m0 = -INFINITY, l0 = 0.f, m1 = -INFINITY, l1 = 0.f;
        for (int j = lane; j <= q; j += 64) {
            const bf16* kr = base + (size_t)j * INC + KOFF; float s0 = 0.f, s1 = 0.f;
            NAIVE_DOT(kr, s0, s1);
            { const float mn = fmaxf(m0, s0); l0 = l0 * exp2f(m0 - mn) + exp2f(s0 - mn); m0 = mn; }
            { const float mn = fmaxf(m1, s1); l1 = l1 * exp2f(m1 - mn) + exp2f(s1 - mn); m1 = mn; }
        }
        const float M0 = wave_max(m0), M1 = wave_max(m1);
        const float L0 = wave_sum(l0 * exp2f(m0 - M0)), L1 = wave_sum(l1 * exp2f(m1 - M1));
        float o0 = 0.f, o1 = 0.f;
        for (int j0 = 0; j0 <= q; j0 += 64) {
            const int j = j0 + lane; float a = 0.f;
            if (j <= q) { const bf16* kr = base + (size_t)j * INC + KOFF; float s0 = 0.f, s1 = 0.f;
                NAIVE_DOT(kr, s0, s1);
                a = exp2f(s0 - M0) / L0 - lam * exp2f(s1 - M1) / L1; }
            af[lane] = a; LDS_WAIT(); asm volatile("" ::: "memory");
            const int nj = (q - j0 + 1) < 64 ? (q - j0 + 1) : 64;
            for (int jj = 0; jj < nj; ++jj) { const unsigned w = *(const unsigned*)(base + (size_t)(j0 + jj) * INC + VOFF + 2 * lane); const float aj = af[jj]; o0 += aj * bflo(w); o1 += aj * bfhi(w); }
            LDS_WAIT(); asm volatile("" ::: "memory");
        }
        const float ss = wave_sum(o0 * o0 + o1 * o1); const float rstd = 1.f / sqrtf(ss * (1.f / 128.f) + NORM_EPS);
        const float g0 = F.g_sub[2 * lane], g1 = F.g_sub[2 * lane + 1];
        *(unsigned*)(F.MIX + (size_t)(b * SEQ + q) * DM + h * 128 + 2 * lane) = pk2(o0 * rstd * g0 * (1.f - LAMBDA_INIT), o1 * rstd * g1 * (1.f - LAMBDA_INIT));
    }
}
#else
namespace att {
constexpr int KT_BYTES = 8192, VT_OFF = 16384, STAGE = 32768;
__device__ __forceinline__ s16x4 vtr(const LAS unsigned char* p) { return __builtin_bit_cast(s16x4, __builtin_amdgcn_ds_read_tr16_b64_v4i16((LAS s16x4*)p)); }
}
__device__ __forceinline__ void p3_attention(Frame& F) {
    using namespace att;
    const int tid = F.tid, lane = F.lane, wid = F.wave, r32 = lane & 31, hi = lane >> 5;
    const int map = wid >> 2, wq = wid & 3;
    const float lam = lambda_full(F);
    LAS unsigned char* L = F.lds + RING_OFF;
    const int krow = tid >> 3, kch = tid & 7;
    const unsigned kdst = (unsigned)(krow * 128 + ((kch ^ ((krow >> 1) & 7)) << 4));
    const int vrow0 = tid >> 4, vrow1 = (tid + 512) >> 4, vch = tid & 15;
    const unsigned vdst0 = (unsigned)(VT_OFF + 256 * vrow0 + 16 * (vch ^ (((vrow0 & 3) << 2) | ((vrow0 >> 2) & 3))));
    const unsigned vdst1 = (unsigned)(VT_OFF + 256 * vrow1 + 16 * (vch ^ (((vrow1 & 3) << 2) | ((vrow1 >> 2) & 3))));
    unsigned koff[4];
#pragma unroll
    for (int d0 = 0; d0 < 4; ++d0) koff[d0] = (unsigned)(map * KT_BYTES + r32 * 128 + ((((2 * d0 + hi) ^ ((r32 >> 1) & 7))) << 4));
    const int vq = (lane & 15) >> 2, vp = lane & 3, vblk = (lane >> 4) & 1;
    unsigned vlow[2];
#pragma unroll
    for (int t = 0; t < 2; ++t) vlow[t] = (unsigned)(VT_OFF + 256 * (8 * t + 4 * hi + vq) + 16 * ((2 * vblk + (vp >> 1)) ^ ((2 * t + hi) & 3)) + 8 * (vp & 1));
    unsigned vcx[4];
#pragma unroll
    for (int c = 0; c < 4; ++c) vcx[c] = (unsigned)((c ^ vq) << 6);

    for (int pr = F.vcu; pr < 256; pr += F.G) {
      const int bh = pr >> 3, b = bh >> 2, h = bh & 3, s8 = pr & 7;
#pragma unroll 1
      for (int half = 0; half < 2; ++half) {
        const int qb = half ? 15 - s8 : s8;
        const int NT = 2 * (qb + 1);
        const int q0w = qb * 128 + wq * 32;
        const bf16* Pb = F.PROJ + (size_t)b * SEQ * INC + h * 128;
        bf16x8 qf[4];
#pragma unroll
        for (int d0 = 0; d0 < 4; ++d0) qf[d0] = *(const bf16x8*)(Pb + (size_t)(q0w + r32) * INC + map * 64 + d0 * 16 + hi * 8);
        f32x16 o[4];
#pragma unroll
        for (int c = 0; c < 4; ++c)
#pragma unroll
            for (int r = 0; r < 16; ++r) o[c][r] = 0.f;
        float mrow = -INFINITY, lrow = 0.f;
        const bf16* kg = Pb + (size_t)krow * INC + KOFF + kch * 8;
        const bf16* vg0 = Pb + (size_t)vrow0 * INC + VOFF + vch * 8;
        const bf16* vg1 = Pb + (size_t)vrow1 * INC + VOFF + vch * 8;
        v4u sk0, sk1, sv0, sv1;
#define ATT_LOAD(t) do { const size_t ro = (size_t)(t) * 64 * INC; sk0 = *(const GAS v4u*)(kg + ro); sk1 = *(const GAS v4u*)(kg + ro + 64); sv0 = *(const GAS v4u*)(vg0 + ro); sv1 = *(const GAS v4u*)(vg1 + ro); } while (0)
#define ATT_STORE(st) do { LAS unsigned char* sb = L + (st) * STAGE; *(LAS v4u*)(sb + kdst) = sk0; *(LAS v4u*)(sb + KT_BYTES + kdst) = sk1; *(LAS v4u*)(sb + vdst0) = sv0; *(LAS v4u*)(sb + vdst1) = sv1; } while (0)
        ATT_LOAD(0); ATT_STORE(0);
        __syncthreads();
#pragma unroll 1
        for (int t = 0; t < NT; ++t) {
            if (t + 1 < NT) ATT_LOAD(t + 1);
            const int kv0 = t * 64;
            if (kv0 <= q0w + 31) {
                const LAS unsigned char* sb = L + (t & 1) * STAGE;
                f32x16 p[2];
#pragma unroll
                for (int kb = 0; kb < 2; ++kb) {
#pragma unroll
                    for (int r = 0; r < 16; ++r) p[kb][r] = 0.f;
#pragma unroll
                    for (int d0 = 0; d0 < 4; ++d0) { const bf16x8 kf = *(const LAS bf16x8*)(sb + kb * 4096 + koff[d0]); p[kb] = __builtin_amdgcn_mfma_f32_32x32x16_bf16(kf, qf[d0], p[kb], 0, 0, 0); }
                }
                if (kv0 + 63 > q0w) {
                    const int qabs = q0w + r32;
#pragma unroll
                    for (int kb = 0; kb < 2; ++kb)
#pragma unroll
                        for (int r = 0; r < 16; ++r) { const int kv = kv0 + 32 * kb + (r & 3) + 8 * (r >> 2) + 4 * hi; if (kv > qabs) p[kb][r] = -INFINITY; }
                }
                float rm = p[0][0];
#pragma unroll
                for (int r = 1; r < 16; ++r) rm = fmaxf(rm, p[0][r]);
#pragma unroll
                for (int r = 0; r < 16; ++r) rm = fmaxf(rm, p[1][r]);
                rm = fmaxf(rm, __shfl_xor(rm, 32));
                const float mnew = fmaxf(mrow, rm);
                const float alpha = __builtin_amdgcn_exp2f(mrow - mnew);
                mrow = mnew;
                float ls = 0.f;
#pragma unroll
                for (int kb = 0; kb < 2; ++kb)
#pragma unroll
                    for (int r = 0; r < 16; ++r) { const float e = __builtin_amdgcn_exp2f(p[kb][r] - mnew); p[kb][r] = e; ls += e; }
                lrow = lrow * alpha + ls;
                if (__any(alpha != 1.0f)) {
#pragma unroll
                    for (int c = 0; c < 4; ++c)
#pragma unroll
                        for (int r = 0; r < 16; ++r) o[c][r] *= alpha;
                }
#pragma unroll
                for (int kb = 0; kb < 2; ++kb)
#pragma unroll
                    for (int s = 0; s < 2; ++s) {
                        v4u pw; pw.x = pk2(p[kb][8 * s + 0], p[kb][8 * s + 1]); pw.y = pk2(p[kb][8 * s + 2], p[kb][8 * s + 3]); pw.z = pk2(p[kb][8 * s + 4], p[kb][8 * s + 5]); pw.w = pk2(p[kb][8 * s + 6], p[kb][8 * s + 7]);
                        const bf16x8 pf = __builtin_bit_cast(bf16x8, pw);
                        const LAS unsigned char* vb = sb + 256 * (32 * kb + 16 * s);
#pragma unroll
                        for (int c = 0; c < 4; ++c) {
                            const s16x4 lo = vtr(vb + vlow[0] + vcx[c]), hh = vtr(vb + vlow[1] + vcx[c]);
                            const bf16x8 vf = (bf16x8){lo[0], lo[1], lo[2], lo[3], hh[0], hh[1], hh[2], hh[3]};
                            o[c] = __builtin_amdgcn_mfma_f32_32x32x16_bf16(vf, pf, o[c], 0, 0, 0);
                        }
                    }
            }
            if (t + 1 < NT) ATT_STORE((t + 1) & 1);
            __syncthreads();
        }
#undef ATT_LOAD
#undef ATT_STORE
        lrow += __shfl_xor(lrow, 32);
        const float inv = 1.0f / lrow;
        LAS float* xb = (LAS float*)L + wq * 4096;
        if (map == 1) {
#pragma unroll
            for (int c = 0; c < 4; ++c)
#pragma unroll
                for (int r = 0; r < 16; ++r) xb[(c * 16 + r) * 64 + lane] = o[c][r] * inv;
        }
        __syncthreads();
        if (map == 0) {
            float ss = 0.f;
#pragma unroll
            for (int c = 0; c < 4; ++c)
#pragma unroll
                for (int r = 0; r < 16; ++r) { const float v = o[c][r] * inv - lam * xb[(c * 16 + r) * 64 + lane]; o[c][r] = v; ss += v * v; }
            ss += __shfl_xor(ss, 32);
            const float rstd = (1.f - LAMBDA_INIT) / sqrtf(ss * (1.f / 128.f) + NORM_EPS);
            bf16* orow = F.MIX + (size_t)(b * SEQ + q0w + r32) * DM + h * 128 + 4 * hi;
#pragma unroll
            for (int c = 0; c < 4; ++c)
#pragma unroll
                for (int g = 0; g < 4; ++g) { const int dv = 32 * c + 8 * g + 4 * hi; const f32x4 gn = *(const f32x4*)(F.g_sub + dv);
                    v2u w; w.x = pk2(o[c][4 * g + 0] * rstd * gn[0], o[c][4 * g + 1] * rstd * gn[1]); w.y = pk2(o[c][4 * g + 2] * rstd * gn[2], o[c][4 * g + 3] * rstd * gn[3]);
                    *(GAS v2u*)(orow + 32 * c + 8 * g) = w; }
        }
        __syncthreads();
      }
    }
}
#endif
__device__ __forceinline__ void p5_router(Frame& F) {
    const int lane = F.lane;
    LAS int* se = (LAS int*)(F.lds + RING_OFF);
    for (int c = F.vcu; c < NTOK / 64; c += F.G) {
#pragma unroll 1
        for (int i = 0; i < 8; ++i) {
            const int tl = F.wave * 8 + i, t = c * 64 + tl;
            const GAS f32x4* hr = (const GAS f32x4*)(F.out + (size_t)t * DM) + lane; const GAS f32x4* gr = (const GAS f32x4*)F.g_ffn + lane;
            f32x4 v[4]; float s = 0.f;
#pragma unroll
            for (int j = 0; j < 4; ++j) { v[j] = hr[64 * j]; s += (v[j].x * v[j].x + v[j].y * v[j].y) + (v[j].z * v[j].z + v[j].w * v[j].w); }
            const float rstd = 1.f / sqrtf(wave_sum(s) * (1.f / DM) + NORM_EPS);
            GAS unsigned long long* o8 = (GAS unsigned long long*)(F.HN2 + (size_t)t * DM) + lane;
#pragma unroll
            for (int j = 0; j < 4; ++j) { const f32x4 g = gr[64 * j]; v[j] = v[j] * rstd * g; o8[64 * j] = (unsigned long long)pk2(v[j].x, v[j].y) | ((unsigned long long)pk2(v[j].z, v[j].w) << 32); }
            f32x4 gl = (f32x4){0.f, 0.f, 0.f, 0.f};
#pragma unroll
            for (int j = 0; j < 4; ++j)
#pragma unroll
                for (int q = 0; q < 4; ++q) { const f32x4 w = *((const GAS f32x4*)F.w_gr + (4 * lane + 256 * j + q)); gl += w * v[j][q]; }
            float g4[4];
#pragma unroll
            for (int a = 0; a < 4; ++a) g4[a] = wave_sum(gl[a]);
            int gs = 0; float gm = g4[0];
#pragma unroll
            for (int a = 1; a < 4; ++a) if (g4[a] > gm) { gm = g4[a]; gs = a; }
            float den = 0.f;
#pragma unroll
            for (int a = 0; a < 4; ++a) den += expf(g4[a] - gm);
            const float ggate = 1.f / den;
            const GAS f32x4* We = (const GAS f32x4*)(F.w_er + (size_t)gs * DM * 8);
            f32x4 e0 = (f32x4){0.f, 0.f, 0.f, 0.f}, e1 = e0;
#pragma unroll
            for (int j = 0; j < 4; ++j)
#pragma unroll
                for (int q = 0; q < 4; ++q) { const int k = 4 * lane + 256 * j + q; const f32x4 w0 = We[2 * k], w1 = We[2 * k + 1]; e0 += w0 * v[j][q]; e1 += w1 * v[j][q]; }
            float el[8];
#pragma unroll
            for (int a = 0; a < 4; ++a) { el[a] = wave_sum(e0[a]); el[4 + a] = wave_sum(e1[a]); }
            int i1 = 0; float v1 = el[0];
#pragma unroll
            for (int a = 1; a < 8; ++a) if (el[a] > v1) { v1 = el[a]; i1 = a; }
            int i2 = -1; float v2 = -INFINITY;
#pragma unroll
            for (int a = 0; a < 8; ++a) if (a != i1 && el[a] > v2) { v2 = el[a]; i2 = a; }
            const float d = expf(v2 - v1), w1 = ggate / (1.f + d), w2 = ggate * d / (1.f + d);
            if (lane == 0) { F.tok_e[2 * t] = gs * 8 + i1; F.tok_e[2 * t + 1] = gs * 8 + i2; F.tok_w[2 * t] = w1; F.tok_w[2 * t + 1] = w2; se[2 * tl] = gs * 8 + i1; se[2 * tl + 1] = gs * 8 + i2; }
        }
        __syncthreads();
        if (F.tid < NE) { int cnt = 0; for (int a = 0; a < 128; ++a) cnt += (se[a] == F.tid) ? 1 : 0; F.ccnt[c * NE + F.tid] = cnt; }
        __syncthreads();
    }
}
__device__ __forceinline__ void p6_slots(Frame& F) {
    const int tid = F.tid, lane = F.lane;
    LAS int* part = (LAS int*)(F.lds + RING_OFF);
    LAS int* cnt = part + 512;
    LAS int* pstart = cnt + 32;
    LAS int* pref = pstart + 32;
    LAS int* se = pref + 32;
    LAS int* dst = se + 128;
    LAS int* tab = (LAS int*)(F.lds + TAB_OFF);
    { const int e = tid & 31, p = tid >> 5; int s = 0; for (int c = p * 16; c < p * 16 + 16; ++c) s += F.ccnt[c * NE + e]; part[p * 32 + e] = s; }
    __syncthreads();
    if (tid < NE) { int s = 0; for (int p = 0; p < 16; ++p) s += part[p * 32 + tid]; cnt[tid] = s; }
    __syncthreads();
    if (tid == 0) { int acc = 0; for (int e = 0; e < NE; ++e) { pstart[e] = acc; const int nt = (cnt[e] + 255) >> 8; for (int i = 0; i < nt; ++i) tab[1 + (acc >> 8) + i] = e; acc += nt << 8; } tab[0] = acc >> 8; }
    __syncthreads();
    if (blockIdx.x == 0) { const int nT = tab[0]; for (int i = tid; i <= nT; i += NWAVES * 64) F.ttab[i] = tab[i]; }
    for (int c = F.vcu; c < NTOK / 64; c += F.G) {
        { const int e = tid & 31, p = tid >> 5; int s = 0; for (int cc = p * 16; cc < p * 16 + 16; ++cc) if (cc < c) s += F.ccnt[cc * NE + e]; part[p * 32 + e] = s; }
        if (tid < 128) se[tid] = F.tok_e[c * 128 + tid];
        __syncthreads();
        if (tid < NE) { int s = 0; for (int p = 0; p < 16; ++p) s += part[p * 32 + tid]; pref[tid] = s; }
        __syncthreads();
        if (tid < 128) { const int e = se[tid]; int r = 0; for (int a = 0; a < tid; ++a) r += (se[a] == e) ? 1 : 0;
            const int d = pstart[e] + pref[e] + r; dst[tid] = d; F.slot_tok[d] = c * 128 + tid; F.slot_w[d] = F.tok_w[c * 128 + tid]; }
        __syncthreads();
#pragma unroll 1
        for (int i = 0; i < 16; ++i) { const int a = F.wave * 16 + i; const int d = dst[a]; const int t = c * 64 + (a >> 1);
            const GAS v4u* src = (const GAS v4u*)(F.HN2 + (size_t)t * DM) + lane; GAS v4u* dp = (GAS v4u*)(F.XG + (size_t)d * DM) + lane;
            const v4u a0 = src[0], a1 = src[64]; dp[0] = a0; dp[64] = a1; }
        __syncthreads();
    }
}
__device__ __forceinline__ int load_tile_table(Frame& F) {
    LAS int* tab = (LAS int*)(F.lds + TAB_OFF);
    int nT = F.ttab[0]; nT = nT < 0 ? 0 : (nT > MAXT ? MAXT : nT);
    for (int i = F.tid; i <= nT; i += NWAVES * 64) tab[i] = F.ttab[i];
    __syncthreads();
    return __builtin_amdgcn_readfirstlane(nT);
}
__device__ __forceinline__ void p9_combine(Frame& F) {
    const int gw = F.vcu * NWAVES + F.wave, NGW = F.G * NWAVES, lane = F.lane;
    for (int t = gw; t < NTOK; t += NGW) {
        GAS f32x4* orow = (GAS f32x4*)(F.out + (size_t)t * DM);
        const GAS v4u* y0 = (const GAS v4u*)(F.Y2 + (size_t)(2 * t) * DM); const GAS v4u* y1 = (const GAS v4u*)(F.Y2 + (size_t)(2 * t + 1) * DM);
#pragma unroll
        for (int j = 0; j < 2; ++j) { const int ch = lane + 64 * j; const v4u a = y0[ch], b = y1[ch]; f32x4 h0 = orow[2 * ch], h1 = orow[2 * ch + 1];
            h0.x += bflo(a.x) + bflo(b.x); h0.y += bfhi(a.x) + bfhi(b.x); h0.z += bflo(a.y) + bflo(b.y); h0.w += bfhi(a.y) + bfhi(b.y);
            h1.x += bflo(a.z) + bflo(b.z); h1.y += bfhi(a.z) + bfhi(b.z); h1.z += bflo(a.w) + bflo(b.w); h1.w += bfhi(a.w) + bfhi(b.w);
            orow[2 * ch] = h0; orow[2 * ch + 1] = h1; }
    }
}
struct Args { const void* in[20]; float* out; unsigned char* ws; int ph_lo, ph_hi, li, pad; };
#if SIMPLE_GEMM
#define RUN_GEMM(EpiT, SchedT, ALIGN, g, S, E) pg8::simple_gemm_phase<EpiT, SchedT>(g, S, E)
#else
#define RUN_GEMM(EpiT, SchedT, ALIGN, g, S, E) pg8::gemm_phase<EpiT, SchedT, ALIGN, true>(F.lds + RING_OFF, g, S, E)
#endif
__global__ void __launch_bounds__(NWAVES * 64, 2) fwd(Args args) {
    extern __shared__ __attribute__((aligned(16))) unsigned char lds[];
    Frame F;
    F.lds = (LAS unsigned char*)lds;
    F.MISC = (volatile LAS unsigned*)(F.lds + MISC_OFF);
    F.tid = threadIdx.x; F.lane = F.tid & 63; F.wave = __builtin_amdgcn_readfirstlane(F.tid >> 6);
    F.G = gridDim.x; { const int bx = blockIdx.x; F.vcu = (F.G % 8 == 0) ? (bx % 8) * (F.G / 8) + bx / 8 : bx; }
    unsigned char* ws = args.ws;
    F.ctl = (gu32*)(ws + WS_CTL);
    F.x = (const float*)args.in[0]; F.pos = (const int*)args.in[1]; F.g_attn = (const float*)args.in[2]; F.w_in = (const float*)args.in[3];
    F.g_q = (const float*)args.in[4]; F.g_k = (const float*)args.in[5]; F.lq1 = (const float*)args.in[6]; F.lk1 = (const float*)args.in[7];
    F.lq2 = (const float*)args.in[8]; F.lk2 = (const float*)args.in[9]; F.g_sub = (const float*)args.in[10]; F.conv_w = (const float*)args.in[11];
    F.g_conv = (const float*)args.in[12]; F.w_out = (const float*)args.in[13]; F.g_ffn = (const float*)args.in[14]; F.w_gr = (const float*)args.in[15];
    F.w_er = (const float*)args.in[16]; F.w_gate = (const float*)args.in[17]; F.w_up = (const float*)args.in[18]; F.w_down = (const float*)args.in[19];
    F.out = args.out;
    F.Wt_in = (bf16*)(ws + WS_WIN); F.Wt_out = (bf16*)(ws + WS_WOUT); F.Wt_gu = (bf16*)(ws + WS_WGU); F.Wt_d = (bf16*)(ws + WS_WD);
    F.HN = (bf16*)args.out;
    F.PROJ = (bf16*)(ws + WS_PROJ); F.MIX = (bf16*)(ws + WS_MIX); F.HN2 = (bf16*)(ws + WS_HN2); F.XG = (bf16*)(ws + WS_XG); F.ACT = (bf16*)(ws + WS_ACT); F.Y2 = (bf16*)(ws + WS_Y2);
    F.tok_e = (int*)(ws + WS_SMALL + SM_TOKE); F.tok_w = (float*)(ws + WS_SMALL + SM_TOKW); F.slot_tok = (int*)(ws + WS_SMALL + SM_SLOTT); F.slot_w = (float*)(ws + WS_SMALL + SM_SLOTW);
    F.ccnt = (int*)(ws + WS_SMALL + SM_CCNT); F.ttab = (int*)(ws + WS_SMALL + SM_TTAB);
    for (int u = F.tid; u < (LDS_BYTES - LDSCTL_OFF) / 4; u += NWAVES * 64) ((LAS unsigned*)(F.lds + LDSCTL_OFF))[u] = 0u;
    __syncthreads();
    XcdBarrier bar; bar.bar = (unsigned*)(F.ctl + CW_BAR); bar.x = 0; bar.st = nullptr;
    if (N_LAUNCHES == 1) bar = xcd_barrier_post((unsigned*)(F.ctl + CW_BAR), F.MISC + 8);
#define GRID_BAR() do { if (N_LAUNCHES == 1) xcd_barrier(bar); } while (0)
    const int lo = args.ph_lo, hi = args.ph_hi;
#define IN(k) (lo <= (k) && (k) < hi)
#define BOTH(k) (IN(k) && IN((k) + 1))

    if (IN(0)) { p0_prologue(F); if (BOTH(0)) GRID_BAR(); }
    if (IN(1)) {
        pg8::Gemm g{F.HN, F.Wt_in, NTOK, INC, DM}; pg8::StaticOrder S; S.init(NTOK, INC, F.G, (int)blockIdx.x);
        pg8::EpiStoreBf16 E{F.PROJ, INC};
        RUN_GEMM(pg8::EpiStoreBf16, pg8::StaticOrder, true, g, S, E);
        if (BOTH(1)) GRID_BAR();
    }
    if (IN(2)) { p2_qk_conv(F); if (BOTH(2)) GRID_BAR(); }
    if (IN(3)) { p3_attention(F); if (BOTH(3)) GRID_BAR(); }
    if (IN(4)) {
        pg8::Gemm g{F.MIX, F.Wt_out, NTOK, DM, DM}; pg8::StaticOrder S; S.init(NTOK, DM, F.G, (int)blockIdx.x);
        pg8::EpiResidual E{F.x, F.out, DM};
        RUN_GEMM(pg8::EpiResidual, pg8::StaticOrder, true, g, S, E);
        if (BOTH(4)) GRID_BAR();
    }
    if (IN(5)) { p5_router(F); if (BOTH(5)) GRID_BAR(); }
    if (IN(6)) { p6_slots(F); if (BOTH(6)) GRID_BAR(); }
    if (IN(7)) {
        const int nT = load_tile_table(F);
        pg8::Gemm g{F.XG, F.Wt_gu, MAXSLOT, NE * 1024, DM}; pg8::MoeOrder S; S.init((const LAS int*)(F.lds + TAB_OFF) + 1, nT, F.G, (int)blockIdx.x);
        pg8::EpiSwiglu E{F.ACT};
        RUN_GEMM(pg8::EpiSwiglu, pg8::MoeOrder, true, g, S, E);
        if (BOTH(7)) GRID_BAR();
    }
    if (IN(8)) {
        const int nT = load_tile_table(F);
        pg8::Gemm g{F.ACT, F.Wt_d, MAXSLOT, NE * 1024, DFF}; pg8::MoeOrder S; S.init((const LAS int*)(F.lds + TAB_OFF) + 1, nT, F.G, (int)blockIdx.x);
        pg8::EpiDown E{F.Y2, F.slot_tok, F.slot_w};
        RUN_GEMM(pg8::EpiDown, pg8::MoeOrder, true, g, S, E);
        if (BOTH(8)) GRID_BAR();
    }
    if (IN(9)) { p9_combine(F); }
#undef IN
#undef BOTH
}

extern "C" void kernel_launch(void* const* d_in, const int* in_sizes, int n_in, void* d_out, int out_size, void* d_ws, size_t ws_size, hipStream_t stream) {
    static int grid = 0;
    if (grid == 0) {
        if (n_in != 20 || in_sizes[0] != NTOK * DM || out_size != NTOK * DM || ws_size < WS_END) { fprintf(stderr, "kernel_launch: unexpected shapes (n_in %d, in0 %d, out %d, ws %zu); nothing launched\n", n_in, n_in > 0 ? in_sizes[0] : -1, out_size, ws_size); grid = -1; return; }
        int dev = 0, cus = 0, per_cu = 0;
        if (hipGetDevice(&dev) != hipSuccess || hipDeviceGetAttribute(&cus, hipDeviceAttributeMultiprocessorCount, dev) != hipSuccess) { grid = -1; return; }
        if (hipFuncSetAttribute((const void*)fwd, hipFuncAttributeMaxDynamicSharedMemorySize, LDS_BYTES) != hipSuccess) { fprintf(stderr, "kernel_launch: hipFuncSetAttribute failed\n"); grid = -1; return; }
        if (hipOccupancyMaxActiveBlocksPerMultiprocessor(&per_cu, (const void*)fwd, NWAVES * 64, LDS_BYTES) != hipSuccess || per_cu < 1) { fprintf(stderr, "kernel_launch: occupancy query reports %d workgroups per CU\n", per_cu); per_cu = 1; }
        (void)hipGetLastError();
        grid = cus;
    }
    if (grid < 0) return;
    if (hipMemsetAsync((char*)d_ws + WS_CTL, 0, CTL_ZERO_BYTES, stream) != hipSuccess) return;
    Args a{};
    for (int i = 0; i < 20; ++i) a.in[i] = d_in[i];
    a.out = (float*)d_out; a.ws = (unsigned char*)d_ws;
    if (N_LAUNCHES == 1) { a.ph_lo = 0; a.ph_hi = PER_PHASE; a.li = 0; hipLaunchKernelGGL(fwd, dim3(grid), dim3(NWAVES * 64), LDS_BYTES, stream, a); }
    else for (int li = 0; li < PER_PHASE; ++li) { a.ph_lo = li; a.ph_hi = li + 1; a.li = li; hipLaunchKernelGGL(fwd, dim3(grid), dim3(NWAVES * 64), LDS_BYTES, stream, a); }
}
```

```cpp
#include <hip/hip_runtime.h>
#include <cstdio>
#include <cstdint>
#ifndef MK_N_LAUNCHES
#define MK_N_LAUNCHES 1
#endif
#ifndef SIMPLE_GEMM
#define SIMPLE_GEMM 0
#endif
#ifndef NAIVE_ATTN
#define NAIVE_ATTN 0
#endif
#ifndef PROBE_DUP
#define PROBE_DUP 0
#endif
#define DUP(k) (((PROBE_DUP) >> (k)) & 1)
namespace pg8 {
#define PG8_LAS __attribute__((address_space(3)))
typedef unsigned short bf16_t;
typedef short bf16x8 __attribute__((ext_vector_type(8)));
typedef float f32x4 __attribute__((ext_vector_type(4)));
typedef unsigned u32x4 __attribute__((ext_vector_type(4)));
constexpr int BM = 256, BK = 64, HALF = 128, HTB = HALF * BK * 2  , STAGE_BYTES = 8 * HTB, NXCD = 8, WGM = 8;

__host__ __device__ __forceinline__ int lds_byte(int r, int c) { const int st = (r >> 4) * 2 + (c >> 5), rr = r & 15, cc = c & 31, ob = rr * 64 + cc * 2; return st * 1024 + (ob ^ (((ob >> 9) & 1) << 5)); }
__host__ __device__ __forceinline__ void stage_rc(int b, int& R, int& C) { const int st = b / 1024, sb = b % 1024, swz = sb ^ (((sb >> 9) & 1) << 5); R = (st >> 1) * 16 + swz / 64; C = (st & 1) * 32 + (swz % 64) / 2; }
__host__ __device__ __forceinline__ int perm32(int rho) { const int n = rho >> 4, i = rho & 15; return 8 * (i >> 2) + 4 * n + (i & 3); }

struct Unit { int pm, pn; };
struct Gemm { const bf16_t* A; const bf16_t* Bt; int M, N, K; const PG8_LAS unsigned* rowoff = nullptr; };

struct StaticOrder {
    int nM, nN, nwg, G, c;
    __host__ __device__ void init(int M, int N, int G_, int c_) { nM = M / BM; nN = N / BM; nwg = nM * nN; G = G_; c = c_; }
    __host__ __device__ bool next(int i, Unit& u) const {
        const long L = (long)i * G + c; if (L >= nwg) return false;
        int wgid = (int)L; { const int q = nwg / NXCD, r = nwg % NXCD, xcd = wgid % NXCD, off = wgid / NXCD; wgid = (xcd < r ? xcd * (q + 1) : r * (q + 1) + (xcd - r) * q) + off; }
        const int nig = WGM * nN, gid = wgid / nig, fm = gid * WGM, gsz = (nM - fm) < WGM ? (nM - fm) : WGM;
        u.pm = fm + ((wgid % nig) % gsz); u.pn = (wgid % nig) / gsz; return true;
    }
    __device__ __forceinline__ void a_ready(const Unit&) const {}
    __device__ __forceinline__ void done(const Unit&) const {}
};

__device__ __forceinline__ unsigned cvt_pk_bf16(float lo, float hi) { unsigned r; asm volatile("v_cvt_pk_bf16_f32 %0, %1, %2" : "=v"(r) : "v"(lo), "v"(hi)); return r; }
typedef unsigned u32x4e __attribute__((ext_vector_type(4)));
struct EpiStoreBf16 {
    static constexpr bool PERM = true, AFTER_DRAIN = false;
    bf16_t* O; int ldc;
    __device__ __forceinline__ void operator()(const f32x4 (&acc)[2][2][4][2], const Unit& u, int wr, int wc, int fr, int fq) const {
        const int row0 = u.pm * BM + wr * 64 + fr, col0 = u.pn * BM + wc * 32 + 8 * fq;
#pragma unroll
        for (int ai = 0; ai < 2; ++ai)
#pragma unroll
            for (int m = 0; m < 4; ++m) { bf16_t* rowp = O + (size_t)(row0 + ai * HALF + m * 16) * ldc + col0;
#pragma unroll
                for (int bj = 0; bj < 2; ++bj) { const f32x4 v0 = acc[ai][bj][m][0], v1 = acc[ai][bj][m][1];
                    u32x4 w; w.x = cvt_pk_bf16(v0[0], v0[1]); w.y = cvt_pk_bf16(v0[2], v0[3]); w.z = cvt_pk_bf16(v1[0], v1[1]); w.w = cvt_pk_bf16(v1[2], v1[3]);
                    *(u32x4*)(rowp + bj * HALF) = w; } }
    }
};
struct EpiResidual {
    static constexpr bool PERM = false, AFTER_DRAIN = false;
    const float* X; float* O; int ldc;
    __device__ __forceinline__ void operator()(const f32x4 (&acc)[2][2][4][2], const Unit& u, int wr, int wc, int fr, int fq) const {
        const int row0 = u.pm * BM + wr * 64 + fr, col0 = u.pn * BM + wc * 32 + 4 * fq;
#pragma unroll
        for (int ai = 0; ai < 2; ++ai)
#pragma unroll
            for (int m = 0; m < 4; ++m) { const size_t off = (size_t)(row0 + ai * HALF + m * 16) * ldc + col0;
#pragma unroll
                for (int bj = 0; bj < 2; ++bj)
#pragma unroll
                    for (int n = 0; n < 2; ++n) { const size_t idx = off + bj * HALF + n * 16; *(f32x4*)(O + idx) = *(const f32x4*)(X + idx) + acc[ai][bj][m][n]; } }
    }
};
__device__ __forceinline__ float swiglu1(float g, float u) { return g * u * __builtin_amdgcn_rcpf(1.0f + __builtin_amdgcn_exp2f(g * -1.4426950408889634f)); }
struct EpiSwiglu {
    static constexpr bool PERM = true, AFTER_DRAIN = false;
    bf16_t* O; const float* slot_rs;
    __device__ __forceinline__ void operator()(const f32x4 (&acc)[2][2][4][2], const Unit& u, int wr, int wc, int fr, int fq) const {
        const int row0 = u.pm * BM + wr * 64 + fr, col0 = (u.pn & 3) * HALF + wc * 32 + 8 * fq;
#pragma unroll
        for (int ai = 0; ai < 2; ++ai)
#pragma unroll
            for (int m = 0; m < 4; ++m) { bf16_t* rowp = O + (size_t)(row0 + ai * HALF + m * 16) * 512 + col0;
                const float rs = slot_rs[row0 + ai * HALF + m * 16];
                const f32x4 g0 = acc[ai][0][m][0] * rs, g1 = acc[ai][0][m][1] * rs, u0 = acc[ai][1][m][0] * rs, u1 = acc[ai][1][m][1] * rs;
                u32x4 w; w.x = cvt_pk_bf16(swiglu1(g0[0], u0[0]), swiglu1(g0[1], u0[1])); w.y = cvt_pk_bf16(swiglu1(g0[2], u0[2]), swiglu1(g0[3], u0[3]));
                w.z = cvt_pk_bf16(swiglu1(g1[0], u1[0]), swiglu1(g1[1], u1[1])); w.w = cvt_pk_bf16(swiglu1(g1[2], u1[2]), swiglu1(g1[3], u1[3]));
                *(u32x4*)rowp = w; }
    }
};
struct EpiDown {
    static constexpr bool PERM = true, AFTER_DRAIN = false;
    bf16_t* Y; const int* slot_tok; const float* slot_w;
    __device__ __forceinline__ void operator()(const f32x4 (&acc)[2][2][4][2], const Unit& u, int wr, int wc, int fr, int fq) const {
        const int slot0 = u.pm * BM + wr * 64 + fr, col0 = (u.pn & 3) * BM + wc * 32 + 8 * fq;
#pragma unroll
        for (int ai = 0; ai < 2; ++ai)
#pragma unroll
            for (int m = 0; m < 4; ++m) { const int slot = slot0 + ai * HALF + m * 16; const int tok = slot_tok[slot];
                if (tok >= 0) { const float sw = slot_w[slot]; bf16_t* rowp = Y + (size_t)tok * 1024 + col0;
#pragma unroll
                    for (int bj = 0; bj < 2; ++bj) { const f32x4 v0 = acc[ai][bj][m][0] * sw, v1 = acc[ai][bj][m][1] * sw;
                        u32x4 w; w.x = cvt_pk_bf16(v0[0], v0[1]); w.y = cvt_pk_bf16(v0[2], v0[3]); w.z = cvt_pk_bf16(v1[0], v1[1]); w.w = cvt_pk_bf16(v1[2], v1[3]);
                        *(u32x4*)(rowp + bj * HALF) = w; } } }
    }
};
struct MoeOrder {
    const PG8_LAS int* tile_e; int nU, q, bpx, xcd, r;
    __device__ __forceinline__ void init(const PG8_LAS int* te, int nT, int G, int c) { tile_e = te; nU = 4 * nT; if (G % 8 == 0) { bpx = G / 8; xcd = c & 7; r = c >> 3; q = (nU + 7) / 8; } else { bpx = G; xcd = 0; r = c; q = nU; } }
    __device__ __forceinline__ bool next(int i, Unit& u) const {
        const int s = i * bpx + r; if (s >= q) return false;
        const int L = xcd * q + s; if (L >= nU) return false;
        const int pm = L >> 2; u.pm = pm; u.pn = __builtin_amdgcn_readfirstlane(tile_e[pm]) * 4 + (L & 3); return true;
    }
    __device__ __forceinline__ void a_ready(const Unit&) const {}
    __device__ __forceinline__ void done(const Unit&) const {}
};
template <class Epi, class Sched>
__device__ __forceinline__ void simple_gemm_phase(const Gemm g, const Sched& S, const Epi& E) {
    const int tid = threadIdx.x, wid = __builtin_amdgcn_readfirstlane(tid >> 6), lane = tid & 63, wr = wid >> 2, wc = wid & 3, fr = lane & 15, fq = lane >> 4;
    Unit u;
    for (int i = 0; S.next(i, u); ++i) {
        f32x4 acc[2][2][4][2];
#pragma unroll
        for (int a = 0; a < 2; ++a)
#pragma unroll
            for (int b = 0; b < 2; ++b)
#pragma unroll
                for (int m = 0; m < 4; ++m)
#pragma unroll
                    for (int n = 0; n < 2; ++n) acc[a][b][m][n] = (f32x4){0.f, 0.f, 0.f, 0.f};
        const bf16_t* Ab = g.A + (size_t)(u.pm * BM + wr * 64 + fr) * g.K + fq * 8;
        const int brow = Epi::PERM ? (wc * 32 + 8 * (fr >> 2) + (fr & 3)) : (wc * 32 + fr);
        const bf16_t* Bb = g.Bt + (size_t)(u.pn * BM + brow) * g.K + fq * 8;
        for (int k0 = 0; k0 < g.K; k0 += 32) {
            bf16x8 a[2][4], b[2][2];
#pragma unroll
            for (int ai = 0; ai < 2; ++ai)
#pragma unroll
                for (int m = 0; m < 4; ++m) a[ai][m] = *(const bf16x8*)(Ab + (size_t)(ai * HALF + m * 16) * g.K + k0);
#pragma unroll
            for (int bj = 0; bj < 2; ++bj)
#pragma unroll
                for (int n = 0; n < 2; ++n) b[bj][n] = *(const bf16x8*)(Bb + (size_t)(bj * HALF + (Epi::PERM ? 4 * n : 16 * n)) * g.K + k0);
#pragma unroll
            for (int ai = 0; ai < 2; ++ai)
#pragma unroll
                for (int bj = 0; bj < 2; ++bj)
#pragma unroll
                    for (int m = 0; m < 4; ++m)
#pragma unroll
                        for (int n = 0; n < 2; ++n) acc[ai][bj][m][n] = __builtin_amdgcn_mfma_f32_16x16x32_bf16(b[bj][n], a[ai][m], acc[ai][bj][m][n], 0, 0, 0);
        }
        E(acc, u, wr, wc, fr, fq);
    }
}
template <class Epi, class Sched, bool ALIGN_EPI = false, bool SP2 = false, bool GATHER = false, bool G64 = false>
__device__ __forceinline__ void gemm_phase(PG8_LAS unsigned char* lds, const Gemm g, const Sched& S, const Epi& E) {
    const int tid = threadIdx.x, wid = __builtin_amdgcn_readfirstlane(tid >> 6), lane = tid & 63, wr = wid >> 2, wc = wid & 3, fr = lane & 15, fq = lane >> 4;
    const int K = g.K, nt = K / BK;
    static_assert(SP2 || (!GATHER && !G64), "GATHER / G64 are implemented on the SP2 loop only");
    unsigned voffA[2], voffB[2], gR[2], gC[2];
#pragma unroll
    for (int i = 0; i < 2; ++i) { int R, C; stage_rc(tid * 16 + i * 8192, R, C); const int Rb = Epi::PERM ? ((R & ~31) + perm32(R & 31)) : R;
        const int RbG = G64 ? ((Rb >> 5) * 64 + (Rb & 31)) : Rb; gR[i] = (unsigned)R; gC[i] = (unsigned)C * 2u;
        voffA[i] = (unsigned)(R * K + C) * 2u; voffB[i] = (unsigned)(RbG * K + C) * 2u; }
    const size_t kstep = (size_t)(BK * 2);
    const size_t hstep = (size_t)HALF * K * 2;
    const size_t tstep = 2 * hstep;
    const size_t hstepB = G64 ? (size_t)32 * K * 2 : hstep;
    const size_t tstepA = GATHER ? 0 : tstep;
    const unsigned ldsw = (unsigned)wid * 1024u;
    const int aoff = lds_byte(wr * 64 + fr, fq * 8), boff = lds_byte(wc * 32 + fr, fq * 8);
#define PG8_SA(b, h) (((b) * 2 + (h)) * HTB)
#define PG8_SB(b, h) ((4 + (b) * 2 + (h)) * HTB)
#define PG8_STAGE(bufoff, gbase, voff) do { _Pragma("unroll") for (int _i = 0; _i < 2; ++_i) \
        __builtin_amdgcn_global_load_lds((const unsigned*)((const char*)(gbase) + (voff)[_i]), (PG8_LAS unsigned*)(lds + (bufoff) + ldsw + _i * 8192), 16, 0, 0); } while (0)
#define PG8_LDA(dst, b, h) do { _Pragma("unroll") for (int m = 0; m < 4; ++m) _Pragma("unroll") for (int k = 0; k < 2; ++k) dst[m][k] = *(const PG8_LAS bf16x8*)(lds + PG8_SA(b, h) + aoff + m * 2048 + k * 1024); } while (0)
#define PG8_LDB(dst, b, h) do { _Pragma("unroll") for (int n = 0; n < 2; ++n) _Pragma("unroll") for (int k = 0; k < 2; ++k) dst[n][k] = *(const PG8_LAS bf16x8*)(lds + PG8_SB(b, h) + boff + n * 2048 + k * 1024); } while (0)
#define PG8_MMA(ai, bj, At, Bt) do { __builtin_amdgcn_s_setprio(1); _Pragma("unroll") for (int m = 0; m < 4; ++m) _Pragma("unroll") for (int n = 0; n < 2; ++n) _Pragma("unroll") for (int k = 0; k < 2; ++k) \
        acc[ai][bj][m][n] = __builtin_amdgcn_mfma_f32_16x16x32_bf16(Bt[n][k], At[m][k], acc[ai][bj][m][n], 0, 0, 0); __builtin_amdgcn_s_setprio(0); } while (0)
#define PG8_STAGE_A(bufoff, gbase, h, nx) do { if constexpr (GATHER) { unsigned vs_[2]; vs_[0] = (nx) ? vN[h][0] : vC[h][0]; vs_[1] = (nx) ? vN[h][1] : vC[h][1]; PG8_STAGE(bufoff, gbase, vs_); } \
        else { PG8_STAGE(bufoff, (gbase) + (h) * hstep, voffA); } } while (0)
#define PG8_GLIST(dst, u_) do { _Pragma("unroll") for (int h_ = 0; h_ < 2; ++h_) _Pragma("unroll") for (int i_ = 0; i_ < 2; ++i_) dst[h_][i_] = g.rowoff[(u_) * 256 + h_ * 128 + gR[i_]] + gC[i_]; } while (0)
#define PG8_WAIT_V(n) asm volatile("s_waitcnt vmcnt(" #n ")" ::: "memory")
#define PG8_WAIT_L(n) asm volatile("s_waitcnt lgkmcnt(" #n ")" ::: "memory")
#define PG8_BAR __builtin_amdgcn_s_barrier()
#define PG8_SCHED __builtin_amdgcn_sched_barrier(0)
    Unit cur, nxt; int ui = 0;
    if (!S.next(0, cur)) return;
    f32x4 acc[2][2][4][2];
#pragma unroll
    for (int a = 0; a < 2; ++a)
#pragma unroll
        for (int b = 0; b < 2; ++b)
#pragma unroll
            for (int m = 0; m < 4; ++m)
#pragma unroll
                for (int n = 0; n < 2; ++n) acc[a][b][m][n] = (f32x4){0.f, 0.f, 0.f, 0.f};
    bf16x8 At[4][2], B0[2][2], B1[2][2];
    const char* cA = (const char*)g.A + (size_t)cur.pm * tstepA; const char* cB = (const char*)g.Bt + (size_t)cur.pn * tstep;
    unsigned vC[2][2], vN[2][2];
    if constexpr (GATHER) { PG8_GLIST(vC, 0); }
    S.a_ready(cur);
    if constexpr (SP2) {
        PG8_STAGE(PG8_SB(0, 0), cB, voffB); PG8_STAGE(PG8_SB(0, 1), cB + hstepB, voffB); PG8_STAGE_A(PG8_SA(0, 0), cA, 0, false); PG8_STAGE_A(PG8_SA(0, 1), cA, 1, false);
        if (wr == 1) PG8_BAR;
        PG8_WAIT_V(2); PG8_BAR;
        PG8_STAGE(PG8_SB(1, 0), cB + kstep, voffB); PG8_STAGE_A(PG8_SA(1, 0), cA + kstep, 0, false); PG8_STAGE(PG8_SB(1, 1), cB + hstepB + kstep, voffB);
        PG8_WAIT_V(6); PG8_BAR;
    } else {
        PG8_STAGE(PG8_SB(0, 0), cB, voffB); PG8_STAGE(PG8_SA(0, 0), cA, voffA); PG8_STAGE(PG8_SB(0, 1), cB + hstep, voffB); PG8_STAGE(PG8_SA(0, 1), cA + hstep, voffA);
        if (wr == 1) PG8_BAR;
        PG8_WAIT_V(4); PG8_BAR;
        PG8_STAGE(PG8_SB(1, 0), cB + kstep, voffB); PG8_STAGE(PG8_SA(1, 0), cA + kstep, voffA); PG8_STAGE(PG8_SB(1, 1), cB + hstep + kstep, voffB);
        PG8_WAIT_V(6); PG8_BAR;
    }
    for (;;) {
        const bool has_next = S.next(ui + 1, nxt);
        if constexpr (GATHER) { if (has_next) { PG8_GLIST(vN, ui + 1); } else { _Pragma("unroll") for (int h_ = 0; h_ < 2; ++h_) _Pragma("unroll") for (int i_ = 0; i_ < 2; ++i_) vN[h_][i_] = vC[h_][i_]; } }
        const char* nA = has_next ? (const char*)g.A + (size_t)nxt.pm * tstepA : cA; const char* nB = has_next ? (const char*)g.Bt + (size_t)nxt.pn * tstep : cB;
        for (int t = 0; t < nt; t += 2) {
            const bool last = (t == nt - 2);
            const char* a1 = cA + (size_t)(t + 1) * kstep;
            const char* a2 = last ? nA : cA + (size_t)(t + 2) * kstep; const char* b2 = last ? nB : cB + (size_t)(t + 2) * kstep;
            const char* a3 = a2 + kstep; const char* b3 = b2 + kstep;
            if (last && has_next) S.a_ready(nxt);
            if constexpr (SP2) {
            PG8_LDB(B0, 0, 0); PG8_LDB(B1, 0, 1); PG8_SCHED; PG8_LDA(At, 0, 0); PG8_STAGE_A(PG8_SA(1, 1), a1, 1, false);
            PG8_WAIT_V(8); PG8_WAIT_L(0); PG8_BAR; PG8_MMA(0, 0, At, B0); PG8_MMA(0, 1, At, B1); PG8_BAR; PG8_SCHED;
            PG8_LDA(At, 0, 1); PG8_STAGE(PG8_SB(0, 0), b2, voffB); PG8_STAGE(PG8_SB(0, 1), b2 + hstepB, voffB); PG8_STAGE_A(PG8_SA(0, 0), a2, 0, last);
            PG8_WAIT_V(8); PG8_WAIT_L(0); PG8_BAR; PG8_MMA(1, 0, At, B0); PG8_MMA(1, 1, At, B1); PG8_BAR; PG8_SCHED;
            PG8_LDB(B0, 1, 0); PG8_LDB(B1, 1, 1); PG8_SCHED; PG8_LDA(At, 1, 0); PG8_STAGE_A(PG8_SA(0, 1), a2, 1, last);
            PG8_WAIT_V(8); PG8_WAIT_L(0); PG8_BAR; PG8_MMA(0, 0, At, B0); PG8_MMA(0, 1, At, B1); PG8_BAR; PG8_SCHED;
            PG8_LDA(At, 1, 1); PG8_STAGE(PG8_SB(1, 0), b3, voffB); PG8_STAGE(PG8_SB(1, 1), b3 + hstepB, voffB); PG8_STAGE_A(PG8_SA(1, 0), a3, 0, last);
            PG8_WAIT_V(8); PG8_WAIT_L(0); PG8_BAR; PG8_MMA(1, 0, At, B0); PG8_MMA(1, 1, At, B1); PG8_BAR; PG8_SCHED;
            } else {
            PG8_LDB(B0, 0, 0); PG8_SCHED; PG8_LDA(At, 0, 0); PG8_STAGE(PG8_SA(1, 1), a1 + hstep, voffA);
            PG8_WAIT_L(8); PG8_BAR; PG8_WAIT_L(0); PG8_MMA(0, 0, At, B0); PG8_BAR; PG8_SCHED;
            PG8_LDB(B1, 0, 1); PG8_STAGE(PG8_SB(0, 0), b2, voffB);
            PG8_BAR; PG8_WAIT_L(0); PG8_MMA(0, 1, At, B1); PG8_BAR;
            PG8_LDA(At, 0, 1); PG8_STAGE(PG8_SA(0, 0), a2, voffA);
            PG8_BAR; PG8_WAIT_L(0); PG8_MMA(1, 0, At, B0); PG8_BAR; PG8_SCHED;
            PG8_STAGE(PG8_SB(0, 1), b2 + hstep, voffB);
            PG8_WAIT_V(6); PG8_BAR; PG8_MMA(1, 1, At, B1); PG8_BAR;
            PG8_LDB(B0, 1, 0); PG8_SCHED; PG8_LDA(At, 1, 0); PG8_STAGE(PG8_SA(0, 1), a2 + hstep, voffA);
            PG8_WAIT_L(8); PG8_BAR; PG8_WAIT_L(0); PG8_MMA(0, 0, At, B0); PG8_BAR; PG8_SCHED;
            PG8_LDB(B1, 1, 1); PG8_STAGE(PG8_SB(1, 0), b3, voffB);
            PG8_BAR; PG8_WAIT_L(0); PG8_MMA(0, 1, At, B1); PG8_BAR;
            PG8_LDA(At, 1, 1); PG8_STAGE(PG8_SA(1, 0), a3, voffA);
            PG8_BAR; PG8_WAIT_L(0); PG8_MMA(1, 0, At, B0); PG8_BAR; PG8_SCHED;
            PG8_STAGE(PG8_SB(1, 1), b3 + hstep, voffB);
            PG8_WAIT_V(6); PG8_BAR; PG8_MMA(1, 1, At, B1); PG8_BAR;
            }
        }
        if constexpr (ALIGN_EPI) { if (wr == 0) PG8_BAR; }
        if constexpr (!Epi::AFTER_DRAIN) { E(acc, cur, wr, wc, fr, fq); S.done(cur); }
        if (!has_next) break;
#pragma unroll
        for (int a = 0; a < 2; ++a)
#pragma unroll
            for (int b = 0; b < 2; ++b)
#pragma unroll
                for (int m = 0; m < 4; ++m)
#pragma unroll
                    for (int n = 0; n < 2; ++n) acc[a][b][m][n] = (f32x4){0.f, 0.f, 0.f, 0.f};
        cur = nxt; cA = nA; cB = nB; ++ui;
        if constexpr (GATHER) { _Pragma("unroll") for (int h_ = 0; h_ < 2; ++h_) _Pragma("unroll") for (int i_ = 0; i_ < 2; ++i_) vC[h_][i_] = vN[h_][i_]; }
        if constexpr (ALIGN_EPI) { if (wr == 1) PG8_BAR; }
    }
    PG8_WAIT_V(0);
    if constexpr (!ALIGN_EPI) { if (wr == 0) PG8_BAR; }
    PG8_BAR;
    if constexpr (Epi::AFTER_DRAIN) { E.fused(acc, cur, wr, wc, fr, fq, lds, wid, lane); S.done(cur); }
#undef PG8_SA
#undef PG8_SB
#undef PG8_STAGE
#undef PG8_STAGE_A
#undef PG8_GLIST
#undef PG8_LDA
#undef PG8_LDB
#undef PG8_MMA
#undef PG8_WAIT_V
#undef PG8_WAIT_L
#undef PG8_BAR
#undef PG8_SCHED
}
}
constexpr int NWAVES = 8;
constexpr int N_LAUNCHES = MK_N_LAUNCHES;
constexpr int PER_PHASE = 10;
constexpr int NTOK = 16384, DM = 1024, SEQ = 2048, NBATCH = 8, NHEAD = 4;
constexpr int INC = 3072;
constexpr int KOFF = 512, VOFF = 1024, CBOFF = 1536, CCOFF = 2048, CUOFF = 2560;
constexpr int NE = 32, DFF = 512, MAXT = 160, MAXSLOT = MAXT * 256;
constexpr float NORM_EPS = 1e-6f;
constexpr float QSCALE = 0.125f * 1.4426950408889634f;
constexpr float LAMBDA_INIT = 0.2f;
constexpr size_t MiB = 1u << 20;
constexpr size_t WS_CTL = 0, CTL_ZERO_BYTES = 65536;
constexpr size_t WS_WIN = 1 * MiB, WS_WOUT = 7 * MiB, WS_WGU = 9 * MiB, WS_WD = 73 * MiB;
constexpr size_t WS_PROJ = 105 * MiB;
constexpr size_t WS_ACT = 105 * MiB;
constexpr size_t WS_Y2 = 145 * MiB;
constexpr size_t WS_MIX = 201 * MiB;
constexpr size_t WS_HN2 = 201 * MiB;
constexpr size_t WS_SMALL = 233 * MiB;
constexpr size_t SM_TOKE = 0, SM_TOKW = 131072, SM_SLOTT = 262144, SM_SLOTW = 262144 + 163840, SM_CCNT = 262144 + 2 * 163840, SM_TTAB = SM_CCNT + 32768, SM_WRH = SM_TTAB + 1024, SM_WRL = SM_WRH + 98304, SM_TOKRS = SM_WRL + 98304, SM_SLOTRS = SM_TOKRS + 65536;
constexpr size_t WS_END = 235 * MiB;
static_assert(WS_ACT + (size_t)MAXSLOT * 512 * 2 <= WS_Y2 && WS_Y2 + (size_t)NTOK * 2 * 1024 * 2 <= WS_SMALL && WS_PROJ + (size_t)NTOK * INC * 2 <= WS_MIX && WS_MIX + (size_t)NTOK * DM * 2 <= WS_SMALL && SM_SLOTRS + 163840 <= 2 * MiB, "d_ws map");
constexpr int CW_TMO = 0, CW_BAR = 4096;
constexpr int RING_OFF = 0, RING_BYTES = 131072;
constexpr int TAB_OFF = RING_BYTES;
constexpr int LIST_OFF = TAB_OFF + 1024, MAXLIST = 8;
constexpr int LDSCTL_OFF = LIST_OFF + MAXLIST * 1024, MISC_OFF = LDSCTL_OFF + 320;
constexpr int LDS_BYTES = 147456;
static_assert(MISC_OFF + 128 <= LDS_BYTES, "LDS map");
#define GAS __attribute__((address_space(1)))
#define LAS __attribute__((address_space(3)))
typedef unsigned short bf16;
typedef unsigned v4u __attribute__((ext_vector_type(4)));
typedef float f32x4 __attribute__((ext_vector_type(4)));
typedef short bf16x8 __attribute__((ext_vector_type(8)));
typedef GAS unsigned gu32;
typedef GAS unsigned long long gu64;
#define RLX_AGENT __ATOMIC_RELAXED, __HIP_MEMORY_SCOPE_AGENT
#define LDS_WAIT() asm volatile("s_waitcnt lgkmcnt(0)" ::: "memory")
#define VM_WAIT() asm volatile("s_waitcnt vmcnt(0)" ::: "memory")
__device__ __forceinline__ unsigned long long rt() { return __builtin_amdgcn_s_memrealtime(); }
__device__ __forceinline__ unsigned f2bf(float f) { unsigned u = __builtin_bit_cast(unsigned, f); return (u + 0x7fffu + ((u >> 16) & 1u)) >> 16; }
typedef float f32x2_t __attribute__((ext_vector_type(2))); typedef __bf16 bf16x2_t __attribute__((ext_vector_type(2)));
__device__ __forceinline__ unsigned pk2(float lo, float hi) { const f32x2_t v = {lo, hi}; const bf16x2_t b = __builtin_convertvector(v, bf16x2_t); return __builtin_bit_cast(unsigned, b); }

#define XB_TMO      128
#define XB_XCNT(j)  (256  + 64 * (j))
#define XB_XSUB(j)  (1280 + 64 * (j))
#define XB_XGEN(j)  (2304 + 64 * (j))
#define XB_TOP      3328
#define XB_TOPGEN   3392
#define XCD_BAR_WORDS 3456
#define XB_SPIN_CAP (1u << 18)

__device__ __forceinline__ unsigned xb_ld(unsigned* p)              { return __hip_atomic_load(p, __ATOMIC_RELAXED, __HIP_MEMORY_SCOPE_AGENT); }
__device__ __forceinline__ unsigned xb_add(unsigned* p, unsigned v) { return __hip_atomic_fetch_add(p, v, __ATOMIC_RELAXED, __HIP_MEMORY_SCOPE_AGENT); }
__device__ __forceinline__ unsigned xb_xcc_id() { return (unsigned)__builtin_amdgcn_s_getreg((3 << 11) | 20) & 0xFu; }
#define XB_SPIN(cond, bar) do { unsigned _sp = 0; while (cond) { __builtin_amdgcn_s_sleep(1); \
    if ((++_sp & 255u) == 0u) { if (xb_ld(&(bar)[XB_TMO])) break; if (_sp > XB_SPIN_CAP) { atomicAdd(&(bar)[XB_TMO], 1u); break; } } } } while (0)

struct XcdBarrier {
    unsigned* bar; unsigned x;
    volatile LAS unsigned* st;
};

__device__ __forceinline__ XcdBarrier xcd_barrier_post(unsigned* bar, volatile LAS unsigned* st) {
    XcdBarrier b; b.bar = bar; b.x = xb_xcc_id(); b.st = st;
    if (threadIdx.x == 0) (void)xb_add(&bar[XB_XCNT(b.x)], 1u);
    return b;
}
__device__ __forceinline__ void xcd_barrier_complete(unsigned* bar, unsigned x, unsigned& nloc, unsigned& nx) {
    const unsigned G = gridDim.x * gridDim.y * gridDim.z;
    unsigned sum, cnt, mine, sp = 0u;
    for (;;) {
        sum = 0u; cnt = 0u; mine = 0u;
#pragma unroll
        for (unsigned j = 0; j < 16; ++j) { const unsigned c = xb_ld(&bar[XB_XCNT(j)]); sum += c; cnt += (c > 0u) ? 1u : 0u; mine = (j == x) ? c : mine; }
        if (sum == G) break;
        __builtin_amdgcn_s_sleep(1);
        if ((++sp & 255u) == 0u) { if (xb_ld(&bar[XB_TMO])) break; if (sp > XB_SPIN_CAP) { atomicAdd(&bar[XB_TMO], 1u); break; } }
    }
    nloc = mine > 0u ? mine : 1u; nx = cnt > 0u ? cnt : 1u;
}

__device__ __forceinline__ void xcd_barrier(const XcdBarrier& b) {
    asm volatile("s_waitcnt vmcnt(0)" ::: "memory");
    __syncthreads();
    if (threadIdx.x == 0) {
        unsigned* bar = b.bar;
        __builtin_amdgcn_s_waitcnt(0);
        unsigned nloc = b.st[0], nx = b.st[1];
        if (nloc == 0u) { xcd_barrier_complete(bar, b.x, nloc, nx); b.st[0] = nloc; b.st[1] = nx; }
        const unsigned old = xb_add(&bar[XB_XSUB(b.x)], 1u);
        const unsigned gen = old / nloc;
        if (old + 1u == (gen + 1u) * nloc) {
            __builtin_amdgcn_fence(__ATOMIC_RELEASE, "agent");
            asm volatile("s_waitcnt vmcnt(0)" ::: "memory");
            const unsigned og = xb_add(&bar[XB_TOP], 1u);
            const unsigned tg = og / nx;
            if (og + 1u == (tg + 1u) * nx) xb_add(&bar[XB_TOPGEN], 1u);
            else XB_SPIN(xb_ld(&bar[XB_TOPGEN]) == tg, bar);
            __builtin_amdgcn_fence(__ATOMIC_ACQUIRE, "agent");
            xb_add(&bar[XB_XGEN(b.x)], 1u);
            asm volatile("s_waitcnt vmcnt(0)" ::: "memory");
        } else {
            XB_SPIN(xb_ld(&bar[XB_XGEN(b.x)]) == gen, bar);
            __builtin_amdgcn_fence(__ATOMIC_ACQUIRE, "agent");
            asm volatile("s_waitcnt vmcnt(0)" ::: "memory");
        }
    }
    __syncthreads();
}
typedef short s16x4 __attribute__((ext_vector_type(4)));
typedef float f32x16 __attribute__((ext_vector_type(16)));
typedef unsigned v2u __attribute__((ext_vector_type(2)));
struct Frame {
    LAS unsigned char* lds;
    volatile LAS unsigned* MISC;
    gu32* ctl;
    int tid, lane, wave;
    int vcu, G;
    const float* x; const int* pos; const float *g_attn, *w_in, *g_q, *g_k, *lq1, *lk1, *lq2, *lk2, *g_sub, *conv_w, *g_conv, *w_out, *g_ffn, *w_gr, *w_er, *w_gate, *w_up, *w_down;
    float* out;
    bf16 *Wt_in, *Wt_out, *Wt_gu, *Wt_d, *Wr_hi, *Wr_lo;
    bf16 *HN, *PROJ, *MIX, *HN2, *ACT, *Y2;
    int* tok_e; float* tok_w; float* tok_rs; int* slot_tok; float* slot_w; float* slot_rs; int* ccnt; int* ttab;
};
__device__ __forceinline__ float wave_sum(float v) {
#pragma unroll
    for (int o = 1; o < 64; o <<= 1) v += __shfl_xor(v, o);
    return v;
}
__device__ __forceinline__ float wave_max(float v) {
#pragma unroll
    for (int o = 1; o < 64; o <<= 1) v = fmaxf(v, __shfl_xor(v, o));
    return v;
}
__device__ __forceinline__ float bf2f(unsigned short b) { return __builtin_bit_cast(float, (unsigned)b << 16); }
__device__ __forceinline__ float bflo(unsigned w) { return __builtin_bit_cast(float, w << 16); }
__device__ __forceinline__ float bfhi(unsigned w) { return __builtin_bit_cast(float, w & 0xffff0000u); }

__device__ __forceinline__ void p0_transpose_item(const float* W, int K, int N, bf16* WT, int k0, int n0, int dst_row0, LAS float* scr, int lane) {
#pragma unroll 8
    for (int i = 0; i < 32; ++i) { const int kk = 2 * i + (lane >> 5); scr[kk * 33 + (lane & 31)] = W[(size_t)(k0 + kk) * N + n0 + (lane & 31)]; }
    LDS_WAIT(); asm volatile("" ::: "memory");
    const int c = lane & 7;
#pragma unroll
    for (int j = 0; j < 4; ++j) { const int n = (lane >> 3) + 8 * j; const LAS float* s = scr + (8 * c) * 33 + n;
        v4u o; o.x = pk2(s[0 * 33], s[1 * 33]); o.y = pk2(s[2 * 33], s[3 * 33]); o.z = pk2(s[4 * 33], s[5 * 33]); o.w = pk2(s[6 * 33], s[7 * 33]);
        *(GAS v4u*)(WT + (size_t)(dst_row0 + n) * K + k0 + 8 * c) = o; }
    LDS_WAIT(); asm volatile("" ::: "memory");
}
__device__ __forceinline__ void rms_row_to_bf16(const float* xrow, const float* gain, bf16* orow, int lane) {
    const GAS f32x4* xr = (const GAS f32x4*)xrow + lane; const GAS f32x4* gr = (const GAS f32x4*)gain + lane;
    f32x4 v[4]; float s = 0.f;
#pragma unroll
    for (int j = 0; j < 4; ++j) { v[j] = xr[64 * j]; s += (v[j].x * v[j].x + v[j].y * v[j].y) + (v[j].z * v[j].z + v[j].w * v[j].w); }
    const float rstd = 1.f / sqrtf(wave_sum(s) * (1.f / DM) + NORM_EPS);
    GAS unsigned long long* o8 = (GAS unsigned long long*)orow + lane;
#pragma unroll
    for (int j = 0; j < 4; ++j) { const f32x4 g = gr[64 * j]; o8[64 * j] = (unsigned long long)pk2(v[j].x * rstd * g.x, v[j].y * rstd * g.y) | ((unsigned long long)pk2(v[j].z * rstd * g.z, v[j].w * rstd * g.w) << 32); }
}
__device__ __forceinline__ void p0_prologue(Frame& F) {
    LAS float* scr = (LAS float*)(F.lds + RING_OFF + F.wave * 16384);
    const int gw = F.vcu * NWAVES + F.wave, NGW = F.G * NWAVES;
    constexpr int I_IN = (DM / 64) * (INC / 32), I_OUT = (DM / 64) * (DM / 32), I_G = (DM / 64) * (DFF / 32), I_D = (DFF / 64) * (DM / 32);
    constexpr int NITEMS = I_IN + I_OUT + NE * (2 * I_G + I_D);
    for (int it = gw; it < NITEMS; it += NGW) {
        int r = it;
        if (r < I_IN) { const int kb = r / (INC / 32), nb = r % (INC / 32); p0_transpose_item(F.w_in, DM, INC, F.Wt_in, 64 * kb, 32 * nb, 32 * nb, scr, F.lane); continue; } r -= I_IN;
        if (r < I_OUT) { const int kb = r / (DM / 32), nb = r % (DM / 32); p0_transpose_item(F.w_out, DM, DM, F.Wt_out, 64 * kb, 32 * nb, 32 * nb, scr, F.lane); continue; } r -= I_OUT;
        const int e = r / (2 * I_G + I_D); r -= e * (2 * I_G + I_D);
        if (r < 2 * I_G) { const int up = r >= I_G; if (up) r -= I_G; const int kb = r / (DFF / 32), nb = r % (DFF / 32), n0 = 32 * nb;
            p0_transpose_item((up ? F.w_up : F.w_gate) + (size_t)e * DM * DFF, DM, DFF, F.Wt_gu, 64 * kb, n0, e * 1024 + (n0 >> 7) * 256 + up * 128 + (n0 & 127), scr, F.lane); continue; }
        r -= 2 * I_G;
        { const int kb = r / (DM / 32), nb = r % (DM / 32); p0_transpose_item(F.w_down + (size_t)e * DFF * DM, DFF, DM, F.Wt_d, 64 * kb, 32 * nb, e * 1024 + 32 * nb, scr, F.lane); }
    }
    for (int m = gw; m < NTOK; m += NGW) rms_row_to_bf16(F.x + (size_t)m * DM, F.g_attn, F.HN + (size_t)m * DM, F.lane);
    for (int i = gw * 64 + F.lane; i < MAXSLOT; i += NGW * 64) F.slot_tok[i] = -1;
    for (int i = gw * 64 + F.lane; i < 48 * DM; i += NGW * 64) { const int cidx = i >> 10, k = i & (DM - 1); float w = 0.f;
        if (cidx < 4) w = F.w_gr[k * 4 + cidx] * F.g_ffn[k]; else if (cidx < 36) { const int e = cidx - 4; w = F.w_er[((size_t)(e >> 3) * DM + k) * 8 + (e & 7)] * F.g_ffn[k]; }
        const unsigned hb = f2bf(w); const float hf = __builtin_bit_cast(float, hb << 16); F.Wr_hi[i] = (bf16)hb; F.Wr_lo[i] = (bf16)f2bf(w - hf); }
}

__device__ __forceinline__ void p2_qk_conv(Frame& F) {
    const int gw = F.vcu * NWAVES + F.wave, NGW = F.G * NWAVES, lane = F.lane;
    const int sub = lane & 7;
    float gq[8], gk[8];
#pragma unroll
    for (int j = 0; j < 8; ++j) { gq[j] = F.g_q[sub * 8 + j] * QSCALE; gk[j] = F.g_k[sub * 8 + j]; }
    float cw0[8], cw1[8], cw2[8], gc[8];
#pragma unroll
    for (int j = 0; j < 8; ++j) { cw0[j] = F.conv_w[lane * 8 + j]; cw1[j] = F.conv_w[512 + lane * 8 + j]; cw2[j] = F.conv_w[1024 + lane * 8 + j]; gc[j] = F.g_conv[lane * 8 + j]; }
    for (int t = gw; t < NTOK; t += NGW) {
        bf16* row = F.PROJ + (size_t)t * INC;
        const float posf = (float)F.pos[t];
        float cs[8], sn[8];
#pragma unroll
        for (int i = 0; i < 8; ++i) { const float fr = exp2f(-(float)i * (18.931568569324174f / 8.0f)); const float ang = posf * fr;
            const float rev = __builtin_amdgcn_fractf(ang * 0.15915494309189535f); cs[i] = __builtin_amdgcn_cosf(rev); sn[i] = __builtin_amdgcn_sinf(rev); }
#pragma unroll
        for (int which = 0; which < 2; ++which) {
            GAS v4u* p = (GAS v4u*)(row + which * KOFF) + lane;
            const v4u w = *p; float v[8];
            v[0] = bflo(w.x); v[1] = bfhi(w.x); v[2] = bflo(w.y); v[3] = bfhi(w.y); v[4] = bflo(w.z); v[5] = bfhi(w.z); v[6] = bflo(w.w); v[7] = bfhi(w.w);
            float ss = 0.f;
#pragma unroll
            for (int j = 0; j < 8; ++j) ss += v[j] * v[j];
            ss += __shfl_xor(ss, 1); ss += __shfl_xor(ss, 2); ss += __shfl_xor(ss, 4);
            const float rstd = 1.f / sqrtf(ss * (1.f / 64.f) + NORM_EPS);
#pragma unroll
            for (int j = 0; j < 8; ++j) v[j] = v[j] * rstd * (which ? gk[j] : gq[j]);
            float o[8];
#pragma unroll
            for (int j = 0; j < 8; ++j) { const float other = __shfl_xor(v[j], 1);
                o[j] = (sub == 0) ? (v[j] * cs[j] - other * sn[j]) : ((sub == 1) ? (v[j] * cs[j] + other * sn[j]) : v[j]); }
            v4u r; r.x = pk2(o[0], o[1]); r.y = pk2(o[2], o[3]); r.z = pk2(o[4], o[5]); r.w = pk2(o[6], o[7]);
            *p = r;
        }
        {
            const int ts = t & (SEQ - 1);
            float z[8];
#pragma unroll
            for (int j = 0; j < 8; ++j) z[j] = 0.f;
#pragma unroll
            for (int d = 0; d < 3; ++d) {
                if (ts - d >= 0) {
                    const bf16* rr = row - (size_t)d * INC;
                    const v4u c = *((const GAS v4u*)(rr + CCOFF) + lane), u = *((const GAS v4u*)(rr + CUOFF) + lane);
                    float y[8];
                    y[0] = bflo(c.x) * bflo(u.x); y[1] = bfhi(c.x) * bfhi(u.x); y[2] = bflo(c.y) * bflo(u.y); y[3] = bfhi(c.y) * bfhi(u.y);
                    y[4] = bflo(c.z) * bflo(u.z); y[5] = bfhi(c.z) * bfhi(u.z); y[6] = bflo(c.w) * bflo(u.w); y[7] = bfhi(c.w) * bfhi(u.w);
#pragma unroll
                    for (int j = 0; j < 8; ++j) z[j] += (d == 0 ? cw2[j] : (d == 1 ? cw1[j] : cw0[j])) * y[j];
                }
            }
            const v4u b = *((const GAS v4u*)(row + CBOFF) + lane);
            float v[8];
            v[0] = bflo(b.x) * z[0]; v[1] = bfhi(b.x) * z[1]; v[2] = bflo(b.y) * z[2]; v[3] = bfhi(b.y) * z[3];
            v[4] = bflo(b.z) * z[4]; v[5] = bfhi(b.z) * z[5]; v[6] = bflo(b.w) * z[6]; v[7] = bfhi(b.w) * z[7];
            float ss = 0.f;
#pragma unroll
            for (int j = 0; j < 8; ++j) ss += v[j] * v[j];
            const float rstd = 1.f / sqrtf(wave_sum(ss) * (1.f / 512.f) + NORM_EPS);
            v4u r; r.x = pk2(v[0] * rstd * gc[0], v[1] * rstd * gc[1]); r.y = pk2(v[2] * rstd * gc[2], v[3] * rstd * gc[3]);
            r.z = pk2(v[4] * rstd * gc[4], v[5] * rstd * gc[5]); r.w = pk2(v[6] * rstd * gc[6], v[7] * rstd * gc[7]);
            *((GAS v4u*)(F.MIX + (size_t)t * DM + 512) + lane) = r;
        }
    }
}
__device__ __forceinline__ float lambda_full(const Frame& F) {
    const int l = F.lane; const float a = wave_sum(F.lq1[l] * F.lk1[l]), b = wave_sum(F.lq2[l] * F.lk2[l]);
    return expf(a) - expf(b) + LAMBDA_INIT;
}
#if NAIVE_ATTN
#define NAIVE_DOT(kr, s0, s1) do { _Pragma("unroll") for (int c_ = 0; c_ < 16; ++c_) { const v4u w_ = *((const GAS v4u*)(kr) + c_); const LAS float* q_ = qs + 8 * c_; \
    const float d_ = q_[0] * bflo(w_.x) + q_[1] * bfhi(w_.x) + q_[2] * bflo(w_.y) + q_[3] * bfhi(w_.y) + q_[4] * bflo(w_.z) + q_[5] * bfhi(w_.z) + q_[6] * bflo(w_.w) + q_[7] * bfhi(w_.w); \
    if (c_ < 8) s0 += d_; else s1 += d_; } } while (0)
__device__ __forceinline__ void p3_attention(Frame& F) {
    const int gw = F.vcu * NWAVES + F.wave, NGW = F.G * NWAVES, lane = F.lane;
    const float lam = lambda_full(F);
    LAS float* qs = (LAS float*)(F.lds + RING_OFF) + F.wave * 256;
    LAS float* af = qs + 128;
    for (int R = gw; R < NBATCH * NHEAD * SEQ; R += NGW) {
        const int bh = R / SEQ, q = R % SEQ, b = bh / NHEAD, h = bh % NHEAD;
        const bf16* base = F.PROJ + (size_t)b * SEQ * INC + h * 128;
        qs[lane] = bf2f(base[(size_t)q * INC + lane]); qs[64 + lane] = bf2f(base[(size_t)q * INC + 64 + lane]);
        LDS_WAIT(); asm volatile("" ::: "memory");
        float m0 = -INFINITY, l0 = 0.f, m1 = -INFINITY, l1 = 0.f;
        for (int j = lane; j <= q; j += 64) {
            const bf16* kr = base + (size_t)j * INC + KOFF; float s0 = 0.f, s1 = 0.f;
            NAIVE_DOT(kr, s0, s1);
            { const float mn = fmaxf(m0, s0); l0 = l0 * exp2f(m0 - mn) + exp2f(s0 - mn); m0 = mn; }
            { const float mn = fmaxf(m1, s1); l1 = l1 * exp2f(m1 - mn) + exp2f(s1 - mn); m1 = mn; }
        }
        const float M0 = wave_max(m0), M1 = wave_max(m1);
        const float L0 = wave_sum(l0 * exp2f(m0 - M0)), L1 = wave_sum(l1 * exp2f(m1 - M1));
        float o0 = 0.f, o1 = 0.f;
        for (int j0 = 0; j0 <= q; j0 += 64) {
            const int j = j0 + lane; float a = 0.f;
            if (j <= q) { const bf16* kr = base + (size_t)j * INC + KOFF; float s0 = 0.f, s1 = 0.f;
                NAIVE_DOT(kr, s0, s1);
                a = exp2f(s0 - M0) / L0 - lam * exp2f(s1 - M1) / L1; }
            af[lane] = a; LDS_WAIT(); asm volatile("" ::: "memory");
            const int nj = (q - j0 + 1) < 64 ? (q - j0 + 1) : 64;
            for (int jj = 0; jj < nj; ++jj) { const unsigned w = *(const unsigned*)(base + (size_t)(j0 + jj) * INC + VOFF + 2 * lane); const float aj = af[jj]; o0 += aj * bflo(w); o1 += aj * bfhi(w); }
            LDS_WAIT(); asm volatile("" ::: "memory");
        }
        const float ss = wave_sum(o0 * o0 + o1 * o1); const float rstd = 1.f / sqrtf(ss * (1.f / 128.f) + NORM_EPS);
        const float g0 = F.g_sub[2 * lane], g1 = F.g_sub[2 * lane + 1];
        *(unsigned*)(F.MIX + (size_t)(b * SEQ + q) * DM + h * 128 + 2 * lane) = pk2(o0 * rstd * g0 * (1.f - LAMBDA_INIT), o1 * rstd * g1 * (1.f - LAMBDA_INIT));
    }
}
#else
namespace att {
constexpr int KT_BYTES = 8192, VT_OFF = 16384, STAGE = 32768;
__device__ __forceinline__ s16x4 vtr(const LAS unsigned char* p) { return __builtin_bit_cast(s16x4, __builtin_amdgcn_ds_read_tr16_b64_v4i16((LAS s16x4*)p)); }
}
__device__ __forceinline__ void p3_attention(Frame& F) {
    using namespace att;
    const int tid = F.tid, lane = F.lane, wid = F.wave, r32 = lane & 31, hi = lane >> 5;
    const int map = wid >> 2, wq = wid & 3;
    const float lam = lambda_full(F);
    LAS unsigned char* L = F.lds + RING_OFF;
    const int krow = tid >> 3, kch = tid & 7;
    const unsigned kdst = (unsigned)(krow * 128 + ((kch ^ ((krow >> 1) & 7)) << 4));
    const int vrow0 = tid >> 4, vrow1 = (tid + 512) >> 4, vch = tid & 15;
    const unsigned vdst0 = (unsigned)(VT_OFF + 256 * vrow0 + 16 * (vch ^ (((vrow0 & 3) << 2) | ((vrow0 >> 2) & 3))));
    const unsigned vdst1 = (unsigned)(VT_OFF + 256 * vrow1 + 16 * (vch ^ (((vrow1 & 3) << 2) | ((vrow1 >> 2) & 3))));
    unsigned koff[4];
#pragma unroll
    for (int d0 = 0; d0 < 4; ++d0) koff[d0] = (unsigned)(map * KT_BYTES + r32 * 128 + ((((2 * d0 + hi) ^ ((r32 >> 1) & 7))) << 4));
    const int vq = (lane & 15) >> 2, vp = lane & 3, vblk = (lane >> 4) & 1;
    unsigned vlow[2];
#pragma unroll
    for (int t = 0; t < 2; ++t) vlow[t] = (unsigned)(VT_OFF + 256 * (8 * t + 4 * hi + vq) + 16 * ((2 * vblk + (vp >> 1)) ^ ((2 * t + hi) & 3)) + 8 * (vp & 1));
    unsigned vcx[4];
#pragma unroll
    for (int c = 0; c < 4; ++c) vcx[c] = (unsigned)((c ^ vq) << 6);

#pragma unroll 1
    for (int rep_ = 0; rep_ < 1 + DUP(3); ++rep_)
    for (int pr = F.vcu; pr < 256; pr += F.G) {
      const int bh = pr >> 3, b = bh >> 2, h = bh & 3, s8 = pr & 7;
#pragma unroll 1
      for (int half = 0; half < 2; ++half) {
        const int qb = half ? 15 - s8 : s8;
        const int NT = 2 * (qb + 1);
        const int q0w = qb * 128 + wq * 32;
        const bf16* Pb = F.PROJ + (size_t)b * SEQ * INC + h * 128;
        bf16x8 qf[4];
#pragma unroll
        for (int d0 = 0; d0 < 4; ++d0) qf[d0] = *(const bf16x8*)(Pb + (size_t)(q0w + r32) * INC + map * 64 + d0 * 16 + hi * 8);
        f32x16 o[4];
#pragma unroll
        for (int c = 0; c < 4; ++c)
#pragma unroll
            for (int r = 0; r < 16; ++r) o[c][r] = 0.f;
        float mrow = -INFINITY, lrow = 0.f;
        const bf16* kg = Pb + (size_t)krow * INC + KOFF + kch * 8;
        const bf16* vg0 = Pb + (size_t)vrow0 * INC + VOFF + vch * 8;
        const bf16* vg1 = Pb + (size_t)vrow1 * INC + VOFF + vch * 8;
        v4u sk0, sk1, sv0, sv1;
#define ATT_LOAD(t) do { const size_t ro = (size_t)(t) * 64 * INC; sk0 = *(const GAS v4u*)(kg + ro); sk1 = *(const GAS v4u*)(kg + ro + 64); sv0 = *(const GAS v4u*)(vg0 + ro); sv1 = *(const GAS v4u*)(vg1 + ro); } while (0)
#define ATT_STORE(st) do { LAS unsigned char* sb = L + (st) * STAGE; *(LAS v4u*)(sb + kdst) = sk0; *(LAS v4u*)(sb + KT_BYTES + kdst) = sk1; *(LAS v4u*)(sb + vdst0) = sv0; *(LAS v4u*)(sb + vdst1) = sv1; } while (0)
        ATT_LOAD(0); ATT_STORE(0);
        __syncthreads();
#pragma unroll 1
        for (int t = 0; t < NT; ++t) {
            if (t + 1 < NT) ATT_LOAD(t + 1);
            const int kv0 = t * 64;
            if (kv0 <= q0w + 31) {
                const LAS unsigned char* sb = L + (t & 1) * STAGE;
                f32x16 p[2];
#pragma unroll
                for (int kb = 0; kb < 2; ++kb) {
#pragma unroll
                    for (int r = 0; r < 16; ++r) p[kb][r] = 0.f;
#pragma unroll
                    for (int d0 = 0; d0 < 4; ++d0) { const bf16x8 kf = *(const LAS bf16x8*)(sb + kb * 4096 + koff[d0]); p[kb] = __builtin_amdgcn_mfma_f32_32x32x16_bf16(kf, qf[d0], p[kb], 0, 0, 0); }
                }
                if (kv0 + 63 > q0w) {
                    const int qabs = q0w + r32;
#pragma unroll
                    for (int kb = 0; kb < 2; ++kb)
#pragma unroll
                        for (int r = 0; r < 16; ++r) { const int kv = kv0 + 32 * kb + (r & 3) + 8 * (r >> 2) + 4 * hi; if (kv > qabs) p[kb][r] = -INFINITY; }
                }
                float rm = p[0][0];
#pragma unroll
                for (int r = 1; r < 16; ++r) rm = fmaxf(rm, p[0][r]);
#pragma unroll
                for (int r = 0; r < 16; ++r) rm = fmaxf(rm, p[1][r]);
                rm = fmaxf(rm, __shfl_xor(rm, 32));
                const float mnew = fmaxf(mrow, rm);
                const float alpha = __builtin_amdgcn_exp2f(mrow - mnew);
                mrow = mnew;
                float ls = 0.f;
#pragma unroll
                for (int kb = 0; kb < 2; ++kb)
#pragma unroll
                    for (int r = 0; r < 16; ++r) { const float e = __builtin_amdgcn_exp2f(p[kb][r] - mnew); p[kb][r] = e; ls += e; }
                lrow = lrow * alpha + ls;
                if (__any(alpha != 1.0f)) {
#pragma unroll
                    for (int c = 0; c < 4; ++c)
#pragma unroll
                        for (int r = 0; r < 16; ++r) o[c][r] *= alpha;
                }
#pragma unroll
                for (int kb = 0; kb < 2; ++kb)
#pragma unroll
                    for (int s = 0; s < 2; ++s) {
                        v4u pw; pw.x = pk2(p[kb][8 * s + 0], p[kb][8 * s + 1]); pw.y = pk2(p[kb][8 * s + 2], p[kb][8 * s + 3]); pw.z = pk2(p[kb][8 * s + 4], p[kb][8 * s + 5]); pw.w = pk2(p[kb][8 * s + 6], p[kb][8 * s + 7]);
                        const bf16x8 pf = __builtin_bit_cast(bf16x8, pw);
                        const LAS unsigned char* vb = sb + 256 * (32 * kb + 16 * s);
#pragma unroll
                        for (int c = 0; c < 4; ++c) {
                            const s16x4 lo = vtr(vb + vlow[0] + vcx[c]), hh = vtr(vb + vlow[1] + vcx[c]);
                            const bf16x8 vf = (bf16x8){lo[0], lo[1], lo[2], lo[3], hh[0], hh[1], hh[2], hh[3]};
                            o[c] = __builtin_amdgcn_mfma_f32_32x32x16_bf16(vf, pf, o[c], 0, 0, 0);
                        }
                    }
            }
            if (t + 1 < NT) ATT_STORE((t + 1) & 1);
            __syncthreads();
        }
#undef ATT_LOAD
#undef ATT_STORE
        lrow += __shfl_xor(lrow, 32);
        const float inv = 1.0f / lrow;
        LAS float* xb = (LAS float*)L + wq * 4096;
        if (map == 1) {
#pragma unroll
            for (int c = 0; c < 4; ++c)
#pragma unroll
                for (int r = 0; r < 16; ++r) xb[(c * 16 + r) * 64 + lane] = o[c][r] * inv;
        }
        __syncthreads();
        if (map == 0) {
            float ss = 0.f;
#pragma unroll
            for (int c = 0; c < 4; ++c)
#pragma unroll
                for (int r = 0; r < 16; ++r) { const float v = o[c][r] * inv - lam * xb[(c * 16 + r) * 64 + lane]; o[c][r] = v; ss += v * v; }
            ss += __shfl_xor(ss, 32);
            const float rstd = (1.f - LAMBDA_INIT) / sqrtf(ss * (1.f / 128.f) + NORM_EPS);
            bf16* orow = F.MIX + (size_t)(b * SEQ + q0w + r32) * DM + h * 128 + 4 * hi;
#pragma unroll
            for (int c = 0; c < 4; ++c)
#pragma unroll
                for (int g = 0; g < 4; ++g) { const int dv = 32 * c + 8 * g + 4 * hi; const f32x4 gn = *(const f32x4*)(F.g_sub + dv);
                    v2u w; w.x = pk2(o[c][4 * g + 0] * rstd * gn[0], o[c][4 * g + 1] * rstd * gn[1]); w.y = pk2(o[c][4 * g + 2] * rstd * gn[2], o[c][4 * g + 3] * rstd * gn[3]);
                    *(GAS v2u*)(orow + 32 * c + 8 * g) = w; }
        }
        __syncthreads();
      }
    }
}
#endif
__device__ __forceinline__ void p5_router(Frame& F) {
    const int lane = F.lane, tid = F.tid, fr = lane & 15, fq = lane >> 4;
    LAS float* LG = (LAS float*)(F.lds + RING_OFF);
    LAS float* SS = LG + 2 * 64 * 48;
    LAS int* cpart = (LAS int*)(SS + 128);
    LAS int* se = cpart + 64;
    const int tt = F.wave & 3, kh = F.wave >> 2;
    for (int c = F.vcu; c < NTOK / 64; c += F.G) {
        {
            const float* hrow = F.out + (size_t)(c * 64 + tt * 16 + fr) * DM + kh * 512 + fq * 8;
            const float* grow = F.g_ffn + kh * 512 + fq * 8; bf16* orow = F.HN2 + (size_t)(c * 64 + tt * 16 + fr) * DM + kh * 512 + fq * 8;
            const bf16* wh = F.Wr_hi + (size_t)fr * DM + kh * 512 + fq * 8; const bf16* wl = F.Wr_lo + (size_t)fr * DM + kh * 512 + fq * 8;
            f32x4 acc[3]; acc[0] = acc[1] = acc[2] = (f32x4){0.f, 0.f, 0.f, 0.f};
            float ss = 0.f;
#pragma unroll 4
            for (int s = 0; s < 16; ++s) {
                const f32x4 a0 = *(const GAS f32x4*)(hrow + 32 * s), a1 = *(const GAS f32x4*)(hrow + 32 * s + 4);
                { const f32x4 g0 = *(const GAS f32x4*)(grow + 32 * s), g1 = *(const GAS f32x4*)(grow + 32 * s + 4); v4u hv; hv.x = pk2(a0.x * g0.x, a0.y * g0.y); hv.y = pk2(a0.z * g0.z, a0.w * g0.w); hv.z = pk2(a1.x * g1.x, a1.y * g1.y); hv.w = pk2(a1.z * g1.z, a1.w * g1.w);
                  *(GAS v4u*)(orow + 32 * s) = hv; }
                ss += (a0.x * a0.x + a0.y * a0.y) + (a0.z * a0.z + a0.w * a0.w) + (a1.x * a1.x + a1.y * a1.y) + (a1.z * a1.z + a1.w * a1.w);
                v4u hi; hi.x = pk2(a0.x, a0.y); hi.y = pk2(a0.z, a0.w); hi.z = pk2(a1.x, a1.y); hi.w = pk2(a1.z, a1.w);
                v4u lo; lo.x = pk2(a0.x - bflo(hi.x), a0.y - bfhi(hi.x)); lo.y = pk2(a0.z - bflo(hi.y), a0.w - bfhi(hi.y)); lo.z = pk2(a1.x - bflo(hi.z), a1.y - bfhi(hi.z)); lo.w = pk2(a1.z - bflo(hi.w), a1.w - bfhi(hi.w));
                const bf16x8 ah = __builtin_bit_cast(bf16x8, hi), al = __builtin_bit_cast(bf16x8, lo);
#pragma unroll
                for (int ct = 0; ct < 3; ++ct) {
                    const bf16x8 bh = *(const GAS bf16x8*)(wh + (size_t)ct * 16 * DM + 32 * s), bl = *(const GAS bf16x8*)(wl + (size_t)ct * 16 * DM + 32 * s);
                    acc[ct] = __builtin_amdgcn_mfma_f32_16x16x32_bf16(ah, bh, acc[ct], 0, 0, 0);
                    acc[ct] = __builtin_amdgcn_mfma_f32_16x16x32_bf16(ah, bl, acc[ct], 0, 0, 0);
                    acc[ct] = __builtin_amdgcn_mfma_f32_16x16x32_bf16(al, bh, acc[ct], 0, 0, 0);
                }
            }
            ss += __shfl_xor(ss, 16); ss += __shfl_xor(ss, 32);
            if (fq == 0) SS[kh * 64 + tt * 16 + fr] = ss;
#pragma unroll
            for (int ct = 0; ct < 3; ++ct)
#pragma unroll
                for (int r = 0; r < 4; ++r) LG[(kh * 64 + tt * 16 + 4 * fq + r) * 48 + ct * 16 + fr] = acc[ct][r];
        }
        __syncthreads();
        if (tid < 64) {
            const int t = c * 64 + tid;
            const float rstd = 1.f / sqrtf((SS[tid] + SS[64 + tid]) * (1.f / DM) + NORM_EPS);
            const LAS float* l0 = LG + tid * 48; const LAS float* l1 = LG + (64 + tid) * 48;
            float g4[4];
#pragma unroll
            for (int a = 0; a < 4; ++a) g4[a] = (l0[a] + l1[a]) * rstd;
            int gs = 0; float gm = g4[0];
#pragma unroll
            for (int a = 1; a < 4; ++a) if (g4[a] > gm) { gm = g4[a]; gs = a; }
            float den = 0.f;
#pragma unroll
            for (int a = 0; a < 4; ++a) den += expf(g4[a] - gm);
            const float ggate = 1.f / den;
            float el[8];
#pragma unroll
            for (int a = 0; a < 8; ++a) el[a] = (l0[4 + gs * 8 + a] + l1[4 + gs * 8 + a]) * rstd;
            int i1 = 0; float v1 = el[0];
#pragma unroll
            for (int a = 1; a < 8; ++a) if (el[a] > v1) { v1 = el[a]; i1 = a; }
            int i2 = -1; float v2 = -INFINITY;
#pragma unroll
            for (int a = 0; a < 8; ++a) if (a != i1 && el[a] > v2) { v2 = el[a]; i2 = a; }
            const float d = expf(v2 - v1), w1 = ggate / (1.f + d), w2 = ggate * d / (1.f + d);
            F.tok_e[2 * t] = gs * 8 + i1; F.tok_e[2 * t + 1] = gs * 8 + i2; F.tok_w[2 * t] = w1; F.tok_w[2 * t + 1] = w2; se[2 * tid] = gs * 8 + i1; se[2 * tid + 1] = gs * 8 + i2;
            F.tok_rs[t] = rstd;
        }
        __syncthreads();
        if (tid < 128) { const int myE = se[tid]; int mycnt = 0;
#pragma unroll 4
            for (int e = 0; e < NE; ++e) { const unsigned long long mk = __ballot(myE == e); if (lane == e) mycnt = __popcll(mk); }
            if (lane < NE) cpart[F.wave * NE + lane] = mycnt; }
        __syncthreads();
        if (tid < NE) F.ccnt[c * NE + tid] = cpart[tid] + cpart[NE + tid];
        __syncthreads();
    }
}
__device__ __forceinline__ void p6_slots(Frame& F) {
    const int tid = F.tid, lane = F.lane;
    LAS int* part = (LAS int*)(F.lds + RING_OFF);
    LAS int* cnt = part + 512;
    LAS int* pstart = cnt + 32;
    LAS int* pref = pstart + 32;
    LAS int* se = pref + 32;
    LAS int* dst = se + 128;
    LAS int* w0cnt = dst + 128;
    LAS int* tab = (LAS int*)(F.lds + TAB_OFF);
    { const int e = tid & 31, p = tid >> 5; int s = 0; for (int c = p * 16; c < p * 16 + 16; ++c) s += F.ccnt[c * NE + e]; part[p * 32 + e] = s; }
    __syncthreads();
    if (tid < NE) { int s = 0; for (int p = 0; p < 16; ++p) s += part[p * 32 + tid]; cnt[tid] = s; }
    __syncthreads();
    if (tid == 0) { int acc = 0; for (int e = 0; e < NE; ++e) { pstart[e] = acc; const int nt = (cnt[e] + 255) >> 8; for (int i = 0; i < nt; ++i) tab[1 + (acc >> 8) + i] = e; acc += nt << 8; } tab[0] = acc >> 8; }
    __syncthreads();
    if (blockIdx.x == 0) { const int nT = tab[0]; for (int i = tid; i <= nT; i += NWAVES * 64) F.ttab[i] = tab[i]; }
    for (int c = F.vcu; c < NTOK / 64; c += F.G) {
        { const int e = tid & 31, p = tid >> 5; int s = 0; for (int cc = p * 16; cc < p * 16 + 16; ++cc) if (cc < c) s += F.ccnt[cc * NE + e]; part[p * 32 + e] = s; }
        if (tid < 128) se[tid] = F.tok_e[c * 128 + tid];
        __syncthreads();
        if (tid < NE) { int s = 0; for (int p = 0; p < 16; ++p) s += part[p * 32 + tid]; pref[tid] = s; }
        __syncthreads();
        int myrank = 0;
        if (tid < 128) { const int e = se[tid]; const unsigned long long below = (1ull << lane) - 1ull;
#pragma unroll 4
            for (int ee = 0; ee < NE; ++ee) { const unsigned long long mk = __ballot(e == ee); if (e == ee) myrank = __popcll(mk & below); if (F.wave == 0 && lane == ee) w0cnt[ee] = __popcll(mk); } }
        __syncthreads();
        if (tid < 128) { const int e = se[tid]; const int r = myrank + (F.wave == 1 ? w0cnt[e] : 0);
            const int d = pstart[e] + pref[e] + r; F.slot_tok[d] = c * 128 + tid; F.slot_w[d] = F.tok_w[c * 128 + tid]; F.slot_rs[d] = F.tok_rs[c * 64 + (tid >> 1)]; }
        __syncthreads();
    }
}
__device__ __forceinline__ int load_tile_table(Frame& F) {
    LAS int* tab = (LAS int*)(F.lds + TAB_OFF);
    int nT = F.ttab[0]; nT = nT < 0 ? 0 : (nT > MAXT ? MAXT : nT);
    for (int i = F.tid; i <= nT; i += NWAVES * 64) tab[i] = F.ttab[i];
    __syncthreads();
    return __builtin_amdgcn_readfirstlane(nT);
}
__device__ __forceinline__ void p9_combine(Frame& F) {
    const int gw = F.vcu * NWAVES + F.wave, NGW = F.G * NWAVES, lane = F.lane;
    for (int t = gw; t < NTOK; t += NGW) {
        GAS f32x4* orow = (GAS f32x4*)(F.out + (size_t)t * DM);
        const GAS v4u* y0 = (const GAS v4u*)(F.Y2 + (size_t)(2 * t) * DM); const GAS v4u* y1 = (const GAS v4u*)(F.Y2 + (size_t)(2 * t + 1) * DM);
#pragma unroll
        for (int j = 0; j < 2; ++j) { const int ch = lane + 64 * j; const v4u a = y0[ch], b = y1[ch]; f32x4 h0 = orow[2 * ch], h1 = orow[2 * ch + 1];
            h0.x += bflo(a.x) + bflo(b.x); h0.y += bfhi(a.x) + bfhi(b.x); h0.z += bflo(a.y) + bflo(b.y); h0.w += bfhi(a.y) + bfhi(b.y);
            h1.x += bflo(a.z) + bflo(b.z); h1.y += bfhi(a.z) + bfhi(b.z); h1.z += bflo(a.w) + bflo(b.w); h1.w += bfhi(a.w) + bfhi(b.w);
            orow[2 * ch] = h0; orow[2 * ch + 1] = h1; }
    }
}
struct Args { const void* in[20]; float* out; unsigned char* ws; int ph_lo, ph_hi, li, pad; };
#if SIMPLE_GEMM
#define RUN_GEMM(EpiT, SchedT, ALIGN, g, S, E) pg8::simple_gemm_phase<EpiT, SchedT>(g, S, E)
#else
#define RUN_GEMM(EpiT, SchedT, ALIGN, g, S, E) pg8::gemm_phase<EpiT, SchedT, ALIGN, true>(F.lds + RING_OFF, g, S, E)
#endif
#define RUN_GEMM_X(EpiT, SchedT, ALIGN, GATHER, G64, g, S, E) pg8::gemm_phase<EpiT, SchedT, ALIGN, true, GATHER, G64>(F.lds + RING_OFF, g, S, E)
__global__ void __launch_bounds__(NWAVES * 64, 2) fwd(Args args) {
    extern __shared__ __attribute__((aligned(16))) unsigned char lds[];
    Frame F;
    F.lds = (LAS unsigned char*)lds;
    F.MISC = (volatile LAS unsigned*)(F.lds + MISC_OFF);
    F.tid = threadIdx.x; F.lane = F.tid & 63; F.wave = __builtin_amdgcn_readfirstlane(F.tid >> 6);
    F.G = gridDim.x; { const int bx = blockIdx.x; F.vcu = (F.G % 8 == 0) ? (bx % 8) * (F.G / 8) + bx / 8 : bx; }
    unsigned char* ws = args.ws;
    F.ctl = (gu32*)(ws + WS_CTL);
    F.x = (const float*)args.in[0]; F.pos = (const int*)args.in[1]; F.g_attn = (const float*)args.in[2]; F.w_in = (const float*)args.in[3];
    F.g_q = (const float*)args.in[4]; F.g_k = (const float*)args.in[5]; F.lq1 = (const float*)args.in[6]; F.lk1 = (const float*)args.in[7];
    F.lq2 = (const float*)args.in[8]; F.lk2 = (const float*)args.in[9]; F.g_sub = (const float*)args.in[10]; F.conv_w = (const float*)args.in[11];
    F.g_conv = (const float*)args.in[12]; F.w_out = (const float*)args.in[13]; F.g_ffn = (const float*)args.in[14]; F.w_gr = (const float*)args.in[15];
    F.w_er = (const float*)args.in[16]; F.w_gate = (const float*)args.in[17]; F.w_up = (const float*)args.in[18]; F.w_down = (const float*)args.in[19];
    F.out = args.out;
    F.Wt_in = (bf16*)(ws + WS_WIN); F.Wt_out = (bf16*)(ws + WS_WOUT); F.Wt_gu = (bf16*)(ws + WS_WGU); F.Wt_d = (bf16*)(ws + WS_WD);
    F.HN = (bf16*)args.out;
    F.PROJ = (bf16*)(ws + WS_PROJ); F.MIX = (bf16*)(ws + WS_MIX); F.HN2 = (bf16*)(ws + WS_HN2); F.ACT = (bf16*)(ws + WS_ACT); F.Y2 = (bf16*)(ws + WS_Y2);
    F.tok_e = (int*)(ws + WS_SMALL + SM_TOKE); F.tok_w = (float*)(ws + WS_SMALL + SM_TOKW); F.slot_tok = (int*)(ws + WS_SMALL + SM_SLOTT); F.slot_w = (float*)(ws + WS_SMALL + SM_SLOTW);
    F.ccnt = (int*)(ws + WS_SMALL + SM_CCNT); F.ttab = (int*)(ws + WS_SMALL + SM_TTAB); F.Wr_hi = (bf16*)(ws + WS_SMALL + SM_WRH); F.Wr_lo = (bf16*)(ws + WS_SMALL + SM_WRL); F.tok_rs = (float*)(ws + WS_SMALL + SM_TOKRS); F.slot_rs = (float*)(ws + WS_SMALL + SM_SLOTRS);
    for (int u = F.tid; u < (LDS_BYTES - LDSCTL_OFF) / 4; u += NWAVES * 64) ((LAS unsigned*)(F.lds + LDSCTL_OFF))[u] = 0u;
    __syncthreads();
    XcdBarrier bar; bar.bar = (unsigned*)(F.ctl + CW_BAR); bar.x = 0; bar.st = nullptr;
    if (N_LAUNCHES == 1) bar = xcd_barrier_post((unsigned*)(F.ctl + CW_BAR), F.MISC + 8);
#define GRID_BAR() do { if (N_LAUNCHES == 1) xcd_barrier(bar); } while (0)
    const int lo = args.ph_lo, hi = args.ph_hi;
#define IN(k) (lo <= (k) && (k) < hi)
#define BOTH(k) (IN(k) && IN((k) + 1))

#define PH0() do { p0_prologue(F); } while (0)
#define PH1() do { pg8::Gemm g{F.HN, F.Wt_in, NTOK, INC, DM}; pg8::StaticOrder S; S.init(NTOK, INC, F.G, (int)blockIdx.x); pg8::EpiStoreBf16 E{F.PROJ, INC}; \
        RUN_GEMM(pg8::EpiStoreBf16, pg8::StaticOrder, true, g, S, E); } while (0)
#define PH2() do { p2_qk_conv(F); } while (0)
#define PH3() do { p3_attention(F); } while (0)
#define PH4() do { pg8::Gemm g{F.MIX, F.Wt_out, NTOK, DM, DM}; pg8::StaticOrder S; S.init(NTOK, DM, F.G, (int)blockIdx.x); pg8::EpiResidual E{F.x, F.out, DM}; \
        RUN_GEMM(pg8::EpiResidual, pg8::StaticOrder, true, g, S, E); } while (0)
#define PH5() do { p5_router(F); } while (0)
#define PH6() do { p6_slots(F); } while (0)
#define PH7() do { const int nT = load_tile_table(F); pg8::MoeOrder S; S.init((const LAS int*)(F.lds + TAB_OFF) + 1, nT, F.G, (int)blockIdx.x); \
        LAS unsigned* lists = (LAS unsigned*)(F.lds + LIST_OFF); \
        { pg8::Unit u_; for (int i_ = 0; i_ < MAXLIST && S.next(i_, u_); ++i_) if (F.tid < 256) { const int tk_ = F.slot_tok[u_.pm * 256 + F.tid]; lists[i_ * 256 + F.tid] = tk_ >= 0 ? (unsigned)(tk_ >> 1) * (unsigned)(DM * 2) : 0u; } } \
        __syncthreads(); \
        pg8::Gemm g{F.HN2, F.Wt_gu, NTOK, NE * 1024, DM, lists}; pg8::EpiSwiglu E{F.ACT, F.slot_rs}; \
        RUN_GEMM_X(pg8::EpiSwiglu, pg8::MoeOrder, true, true, false, g, S, E); } while (0)
#define PH8() do { const int nT = load_tile_table(F); pg8::Gemm g{F.ACT, F.Wt_d, MAXSLOT, NE * 1024, DFF}; pg8::MoeOrder S; S.init((const LAS int*)(F.lds + TAB_OFF) + 1, nT, F.G, (int)blockIdx.x); \
        pg8::EpiDown E{F.Y2, F.slot_tok, F.slot_w}; RUN_GEMM(pg8::EpiDown, pg8::MoeOrder, true, g, S, E); } while (0)
#define PH9() do { p9_combine(F); } while (0)
#define PHASE(k, BODY) if (IN(k)) { BODY(); if (DUP(k) && (k) != 3) { __syncthreads(); BODY(); } if (BOTH(k)) GRID_BAR(); }
    PHASE(0, PH0) PHASE(1, PH1) PHASE(2, PH2) PHASE(3, PH3) PHASE(4, PH4) PHASE(5, PH5) PHASE(6, PH6) PHASE(7, PH7) PHASE(8, PH8)
    if (IN(9)) { PH9(); }
#undef IN
#undef BOTH
}

extern "C" void kernel_launch(void* const* d_in, const int* in_sizes, int n_in, void* d_out, int out_size, void* d_ws, size_t ws_size, hipStream_t stream) {
    static int grid = 0;
    if (grid == 0) {
        if (n_in != 20 || in_sizes[0] != NTOK * DM || out_size != NTOK * DM || ws_size < WS_END) { fprintf(stderr, "kernel_launch: unexpected shapes (n_in %d, in0 %d, out %d, ws %zu); nothing launched\n", n_in, n_in > 0 ? in_sizes[0] : -1, out_size, ws_size); grid = -1; return; }
        int dev = 0, cus = 0, per_cu = 0;
        if (hipGetDevice(&dev) != hipSuccess || hipDeviceGetAttribute(&cus, hipDeviceAttributeMultiprocessorCount, dev) != hipSuccess) { grid = -1; return; }
        if (hipFuncSetAttribute((const void*)fwd, hipFuncAttributeMaxDynamicSharedMemorySize, LDS_BYTES) != hipSuccess) { fprintf(stderr, "kernel_launch: hipFuncSetAttribute failed\n"); grid = -1; return; }
        if (hipOccupancyMaxActiveBlocksPerMultiprocessor(&per_cu, (const void*)fwd, NWAVES * 64, LDS_BYTES) != hipSuccess || per_cu < 1) { fprintf(stderr, "kernel_launch: occupancy query reports %d workgroups per CU\n", per_cu); per_cu = 1; }
        (void)hipGetLastError();
        grid = cus;
    }
    if (grid < 0) return;
    if (hipMemsetAsync((char*)d_ws + WS_CTL, 0, CTL_ZERO_BYTES, stream) != hipSuccess) return;
    Args a{};
    for (int i = 0; i < 20; ++i) a.in[i] = d_in[i];
    a.out = (float*)d_out; a.ws = (unsigned char*)d_ws;
    if (N_LAUNCHES == 1) { a.ph_lo = 0; a.ph_hi = PER_PHASE; a.li = 0; hipLaunchKernelGGL(fwd, dim3(grid), dim3(NWAVES * 64), LDS_BYTES, stream, a); }
    else for (int li = 0; li < PER_PHASE; ++li) { a.ph_lo = li; a.ph_hi = li + 1; a.li = li; hipLaunchKernelGGL(fwd, dim3(grid), dim3(NWAVES * 64), LDS_BYTES, stream, a); }
}
```

```cpp
#include <hip/hip_runtime.h>
#include <cstdio>
#include <cstdint>
#ifndef MK_N_LAUNCHES
#define MK_N_LAUNCHES 1
#endif
#ifndef SIMPLE_GEMM
#define SIMPLE_GEMM 0
#endif
#ifndef NAIVE_ATTN
#define NAIVE_ATTN 0
#endif
#ifndef PROBE_DUP
#define PROBE_DUP 0
#endif
#define DUP(k) (((PROBE_DUP) >> (k)) & 1)
#ifndef PROBE_XBAR
#define PROBE_XBAR 0
#endif
#ifndef ATT_STAGGER
#define ATT_STAGGER 0
#endif
#ifndef MOE_FP8
#define MOE_FP8 1
#endif
#ifndef MOE_FP8_DOWN
#define MOE_FP8_DOWN 0
#endif
namespace pg8 {
#define PG8_LAS __attribute__((address_space(3)))
typedef unsigned short bf16_t;
typedef short bf16x8 __attribute__((ext_vector_type(8)));
typedef float f32x4 __attribute__((ext_vector_type(4)));
typedef unsigned u32x4 __attribute__((ext_vector_type(4)));
constexpr int BM = 256, BK = 64, HALF = 128, HTB = HALF * BK * 2  , STAGE_BYTES = 8 * HTB, NXCD = 8, WGM = 8;

__host__ __device__ __forceinline__ int lds_byte(int r, int c) { const int st = (r >> 4) * 2 + (c >> 5), rr = r & 15, cc = c & 31, ob = rr * 64 + cc * 2; return st * 1024 + (ob ^ (((ob >> 9) & 1) << 5)); }
__host__ __device__ __forceinline__ void stage_rc(int b, int& R, int& C) { const int st = b / 1024, sb = b % 1024, swz = sb ^ (((sb >> 9) & 1) << 5); R = (st >> 1) * 16 + swz / 64; C = (st & 1) * 32 + (swz % 64) / 2; }
__host__ __device__ __forceinline__ int perm32(int rho) { const int n = rho >> 4, i = rho & 15; return 8 * (i >> 2) + 4 * n + (i & 3); }

struct Unit { int pm, pn; };
struct Gemm { const bf16_t* A; const bf16_t* Bt; int M, N, K; const PG8_LAS unsigned* rowoff = nullptr; };

struct StaticOrder {
    int nM, nN, nwg, G, c;
    __host__ __device__ void init(int M, int N, int G_, int c_) { nM = M / BM; nN = N / BM; nwg = nM * nN; G = G_; c = c_; }
    __host__ __device__ bool next(int i, Unit& u) const {
        const long L = (long)i * G + c; if (L >= nwg) return false;
        int wgid = (int)L; { const int q = nwg / NXCD, r = nwg % NXCD, xcd = wgid % NXCD, off = wgid / NXCD; wgid = (xcd < r ? xcd * (q + 1) : r * (q + 1) + (xcd - r) * q) + off; }
        const int nig = WGM * nN, gid = wgid / nig, fm = gid * WGM, gsz = (nM - fm) < WGM ? (nM - fm) : WGM;
        u.pm = fm + ((wgid % nig) % gsz); u.pn = (wgid % nig) / gsz; return true;
    }
    __device__ __forceinline__ void a_ready(const Unit&) const {}
    __device__ __forceinline__ void done(const Unit&) const {}
};

__device__ __forceinline__ unsigned cvt_pk_bf16(float lo, float hi) { unsigned r; asm volatile("v_cvt_pk_bf16_f32 %0, %1, %2" : "=v"(r) : "v"(lo), "v"(hi)); return r; }
typedef unsigned u32x4e __attribute__((ext_vector_type(4)));
struct EpiStoreBf16 {
    static constexpr bool PERM = true, AFTER_DRAIN = false;
    bf16_t* O; int ldc;
    __device__ __forceinline__ void operator()(const f32x4 (&acc)[2][2][4][2], const Unit& u, int wr, int wc, int fr, int fq) const {
        const int row0 = u.pm * BM + wr * 64 + fr, col0 = u.pn * BM + wc * 32 + 8 * fq;
#pragma unroll
        for (int ai = 0; ai < 2; ++ai)
#pragma unroll
            for (int m = 0; m < 4; ++m) { bf16_t* rowp = O + (size_t)(row0 + ai * HALF + m * 16) * ldc + col0;
#pragma unroll
                for (int bj = 0; bj < 2; ++bj) { const f32x4 v0 = acc[ai][bj][m][0], v1 = acc[ai][bj][m][1];
                    u32x4 w; w.x = cvt_pk_bf16(v0[0], v0[1]); w.y = cvt_pk_bf16(v0[2], v0[3]); w.z = cvt_pk_bf16(v1[0], v1[1]); w.w = cvt_pk_bf16(v1[2], v1[3]);
                    *(u32x4*)(rowp + bj * HALF) = w; } }
    }
};
struct EpiProjQK {
    static constexpr bool PERM = true, AFTER_DRAIN = false;
    bf16_t* O; int ldc; const float* gq; const float* gk; const float* cs; float qscale, eps;
    __device__ __forceinline__ void operator()(const f32x4 (&acc)[2][2][4][2], const Unit& u, int wr, int wc, int fr, int fq) const {
        const int row0 = u.pm * BM + wr * 64 + fr, col0 = u.pn * BM + wc * 64 + 8 * fq;
        if (u.pn < 4) {
            const float* gsrc = u.pn < 2 ? gq : gk; const float gs = u.pn < 2 ? qscale : 1.0f;
            f32x4 gv[2][2];
#pragma unroll
            for (int bj = 0; bj < 2; ++bj)
#pragma unroll
                for (int n = 0; n < 2; ++n) gv[bj][n] = *(const f32x4*)(gsrc + 32 * bj + 8 * fq + 4 * n) * gs;
#pragma unroll
            for (int ai = 0; ai < 2; ++ai)
#pragma unroll
                for (int m = 0; m < 4; ++m) { const int row = row0 + ai * HALF + m * 16;
                    float ss = 0.f;
#pragma unroll
                    for (int bj = 0; bj < 2; ++bj)
#pragma unroll
                        for (int n = 0; n < 2; ++n) { const f32x4 v = acc[ai][bj][m][n]; ss += (v[0] * v[0] + v[1] * v[1]) + (v[2] * v[2] + v[3] * v[3]); }
                    ss += __shfl_xor(ss, 16); ss += __shfl_xor(ss, 32);
                    const float rstd = 1.0f / sqrtf(ss * (1.0f / 64.0f) + eps);
                    f32x4 v[2][2];
#pragma unroll
                    for (int bj = 0; bj < 2; ++bj)
#pragma unroll
                        for (int n = 0; n < 2; ++n) v[bj][n] = acc[ai][bj][m][n] * rstd * gv[bj][n];
                    const float* cr = cs + (size_t)row * 16;
#pragma unroll
                    for (int n = 0; n < 2; ++n) { const f32x4 c = *(const f32x4*)(cr + 4 * n), s = *(const f32x4*)(cr + 8 + 4 * n); f32x4 o;
#pragma unroll
                        for (int r = 0; r < 4; ++r) { const float mine = v[0][n][r], other = __shfl_xor(mine, 16); o[r] = fq == 0 ? (mine * c[r] - other * s[r]) : (fq == 1 ? (mine * c[r] + other * s[r]) : mine); }
                        v[0][n] = o; }
                    bf16_t* rowp = O + (size_t)row * ldc + col0;
#pragma unroll
                    for (int bj = 0; bj < 2; ++bj) { u32x4 w; w.x = cvt_pk_bf16(v[bj][0][0], v[bj][0][1]); w.y = cvt_pk_bf16(v[bj][0][2], v[bj][0][3]); w.z = cvt_pk_bf16(v[bj][1][0], v[bj][1][1]); w.w = cvt_pk_bf16(v[bj][1][2], v[bj][1][3]);
                        *(u32x4*)(rowp + bj * 32) = w; } }
        } else {
#pragma unroll
            for (int ai = 0; ai < 2; ++ai)
#pragma unroll
                for (int m = 0; m < 4; ++m) { bf16_t* rowp = O + (size_t)(row0 + ai * HALF + m * 16) * ldc + col0;
#pragma unroll
                    for (int bj = 0; bj < 2; ++bj) { const f32x4 v0 = acc[ai][bj][m][0], v1 = acc[ai][bj][m][1];
                        u32x4 w; w.x = cvt_pk_bf16(v0[0], v0[1]); w.y = cvt_pk_bf16(v0[2], v0[3]); w.z = cvt_pk_bf16(v1[0], v1[1]); w.w = cvt_pk_bf16(v1[2], v1[3]);
                        *(u32x4*)(rowp + bj * 32) = w; } }
        }
    }
};
struct EpiResidual {
    static constexpr bool PERM = false, AFTER_DRAIN = false;
    const float* X; float* O; int ldc;
    __device__ __forceinline__ void operator()(const f32x4 (&acc)[2][2][4][2], const Unit& u, int wr, int wc, int fr, int fq) const {
        const int row0 = u.pm * BM + wr * 64 + fr, col0 = u.pn * BM + wc * 32 + 4 * fq;
#pragma unroll
        for (int ai = 0; ai < 2; ++ai)
#pragma unroll
            for (int m = 0; m < 4; ++m) { const size_t off = (size_t)(row0 + ai * HALF + m * 16) * ldc + col0;
#pragma unroll
                for (int bj = 0; bj < 2; ++bj)
#pragma unroll
                    for (int n = 0; n < 2; ++n) { const size_t idx = off + bj * HALF + n * 16; *(f32x4*)(O + idx) = *(const f32x4*)(X + idx) + acc[ai][bj][m][n]; } }
    }
};
__device__ __forceinline__ float swiglu1(float g, float u) { return g * u * __builtin_amdgcn_rcpf(1.0f + __builtin_amdgcn_exp2f(g * -1.4426950408889634f)); }
__device__ __forceinline__ unsigned pk4_fp8(float a, float b, float c, float d) { int w = 0; w = __builtin_amdgcn_cvt_pk_fp8_f32(a, b, w, false); w = __builtin_amdgcn_cvt_pk_fp8_f32(c, d, w, true); return (unsigned)w; }
template <bool FP8OUT> struct EpiSwiglu {
    static constexpr bool PERM = true, AFTER_DRAIN = false;
    void* O; const float* slot_rs; float inscale;
    __device__ __forceinline__ void operator()(const f32x4 (&acc)[2][2][4][2], const Unit& u, int wr, int wc, int fr, int fq) const {
        const int row0 = u.pm * BM + wr * 64 + fr, col0 = (u.pn & 3) * HALF + wc * 32 + 8 * fq;
#pragma unroll
        for (int ai = 0; ai < 2; ++ai)
#pragma unroll
            for (int m = 0; m < 4; ++m) { const int row = row0 + ai * HALF + m * 16;
                const float rs = slot_rs[row] * inscale;
                const f32x4 g0 = acc[ai][0][m][0] * rs, g1 = acc[ai][0][m][1] * rs, u0 = acc[ai][1][m][0] * rs, u1 = acc[ai][1][m][1] * rs;
                if constexpr (FP8OUT) { typedef unsigned u32x2 __attribute__((ext_vector_type(2))); u32x2 w;
                    w.x = pk4_fp8(swiglu1(g0[0], u0[0]), swiglu1(g0[1], u0[1]), swiglu1(g0[2], u0[2]), swiglu1(g0[3], u0[3]));
                    w.y = pk4_fp8(swiglu1(g1[0], u1[0]), swiglu1(g1[1], u1[1]), swiglu1(g1[2], u1[2]), swiglu1(g1[3], u1[3]));
                    *(u32x2*)((unsigned char*)O + (size_t)row * 512 + col0) = w; }
                else { u32x4 w; w.x = cvt_pk_bf16(swiglu1(g0[0], u0[0]), swiglu1(g0[1], u0[1])); w.y = cvt_pk_bf16(swiglu1(g0[2], u0[2]), swiglu1(g0[3], u0[3]));
                    w.z = cvt_pk_bf16(swiglu1(g1[0], u1[0]), swiglu1(g1[1], u1[1])); w.w = cvt_pk_bf16(swiglu1(g1[2], u1[2]), swiglu1(g1[3], u1[3]));
                    *(u32x4*)((bf16_t*)O + (size_t)row * 512 + col0) = w; } }
    }
};
struct EpiDown {
    static constexpr bool PERM = true, AFTER_DRAIN = false;
    bf16_t* Y; const int* slot_tok; const float* slot_w; float outscale;
    __device__ __forceinline__ void operator()(const f32x4 (&acc)[2][2][4][2], const Unit& u, int wr, int wc, int fr, int fq) const {
        const int slot0 = u.pm * BM + wr * 64 + fr, col0 = (u.pn & 3) * BM + wc * 32 + 8 * fq;
#pragma unroll
        for (int ai = 0; ai < 2; ++ai)
#pragma unroll
            for (int m = 0; m < 4; ++m) { const int slot = slot0 + ai * HALF + m * 16; const int tok = slot_tok[slot];
                if (tok >= 0) { const float sw = slot_w[slot] * outscale; bf16_t* rowp = Y + (size_t)tok * 1024 + col0;
#pragma unroll
                    for (int bj = 0; bj < 2; ++bj) { const f32x4 v0 = acc[ai][bj][m][0] * sw, v1 = acc[ai][bj][m][1] * sw;
                        u32x4 w; w.x = cvt_pk_bf16(v0[0], v0[1]); w.y = cvt_pk_bf16(v0[2], v0[3]); w.z = cvt_pk_bf16(v1[0], v1[1]); w.w = cvt_pk_bf16(v1[2], v1[3]);
                        *(u32x4*)(rowp + bj * HALF) = w; } } }
    }
};
struct MoeOrder {
    const PG8_LAS int* tile_e; int nU, q, bpx, xcd, r;
    __device__ __forceinline__ void init(const PG8_LAS int* te, int nT, int G, int c) { tile_e = te; nU = 4 * nT; if (G % 8 == 0) { bpx = G / 8; xcd = c & 7; r = c >> 3; q = (nU + 7) / 8; } else { bpx = G; xcd = 0; r = c; q = nU; } }
    __device__ __forceinline__ bool next(int i, Unit& u) const {
        const int s = i * bpx + r; if (s >= q) return false;
        const int L = xcd * q + s; if (L >= nU) return false;
        const int pm = L >> 2; u.pm = pm; u.pn = __builtin_amdgcn_readfirstlane(tile_e[pm]) * 4 + (L & 3); return true;
    }
    __device__ __forceinline__ void a_ready(const Unit&) const {}
    __device__ __forceinline__ void done(const Unit&) const {}
};
template <class Epi, class Sched>
__device__ __forceinline__ void simple_gemm_phase(const Gemm g, const Sched& S, const Epi& E) {
    const int tid = threadIdx.x, wid = __builtin_amdgcn_readfirstlane(tid >> 6), lane = tid & 63, wr = wid >> 2, wc = wid & 3, fr = lane & 15, fq = lane >> 4;
    Unit u;
    for (int i = 0; S.next(i, u); ++i) {
        f32x4 acc[2][2][4][2];
#pragma unroll
        for (int a = 0; a < 2; ++a)
#pragma unroll
            for (int b = 0; b < 2; ++b)
#pragma unroll
                for (int m = 0; m < 4; ++m)
#pragma unroll
                    for (int n = 0; n < 2; ++n) acc[a][b][m][n] = (f32x4){0.f, 0.f, 0.f, 0.f};
        const bf16_t* Ab = g.A + (size_t)(u.pm * BM + wr * 64 + fr) * g.K + fq * 8;
        const int brow = Epi::PERM ? (wc * 32 + 8 * (fr >> 2) + (fr & 3)) : (wc * 32 + fr);
        const bf16_t* Bb = g.Bt + (size_t)(u.pn * BM + brow) * g.K + fq * 8;
        for (int k0 = 0; k0 < g.K; k0 += 32) {
            bf16x8 a[2][4], b[2][2];
#pragma unroll
            for (int ai = 0; ai < 2; ++ai)
#pragma unroll
                for (int m = 0; m < 4; ++m) a[ai][m] = *(const bf16x8*)(Ab + (size_t)(ai * HALF + m * 16) * g.K + k0);
#pragma unroll
            for (int bj = 0; bj < 2; ++bj)
#pragma unroll
                for (int n = 0; n < 2; ++n) b[bj][n] = *(const bf16x8*)(Bb + (size_t)(bj * HALF + (Epi::PERM ? 4 * n : 16 * n)) * g.K + k0);
#pragma unroll
            for (int ai = 0; ai < 2; ++ai)
#pragma unroll
                for (int bj = 0; bj < 2; ++bj)
#pragma unroll
                    for (int m = 0; m < 4; ++m)
#pragma unroll
                        for (int n = 0; n < 2; ++n) acc[ai][bj][m][n] = __builtin_amdgcn_mfma_f32_16x16x32_bf16(b[bj][n], a[ai][m], acc[ai][bj][m][n], 0, 0, 0);
        }
        E(acc, u, wr, wc, fr, fq);
    }
}
template <class Epi, class Sched, bool ALIGN_EPI = false, bool SP2 = false, bool GATHER = false, bool G64 = false, bool FP8 = false>
__device__ __forceinline__ void gemm_phase(PG8_LAS unsigned char* lds, const Gemm g, const Sched& S, const Epi& E, const int wave_  ) {
    int tid_ = wave_ * 64 + (int)__builtin_amdgcn_mbcnt_hi(~0u, __builtin_amdgcn_mbcnt_lo(~0u, 0u)); asm volatile("" : "+v"(tid_));
    const int tid = tid_, wid = __builtin_amdgcn_readfirstlane(tid >> 6), lane = tid & 63, wr = wid >> 2, wc = wid & 3, fr = lane & 15, fq = lane >> 4;
    const int K = g.K, nt = K / BK;
    static_assert(SP2 || (!GATHER && !G64), "GATHER / G64 are implemented on the SP2 loop only");
    unsigned voffA[2], voffB[2];
#pragma unroll
    for (int i = 0; i < 2; ++i) { int R, C; stage_rc(tid * 16 + i * 8192, R, C); const int Rb = Epi::PERM ? ((R & ~31) + perm32(R & 31)) : R;
        const int RbG = G64 ? ((Rb >> 5) * 64 + (Rb & 31)) : Rb;
        voffA[i] = (unsigned)(R * K + C) * 2u; voffB[i] = (unsigned)(RbG * K + C) * 2u; }
    const size_t kstep = (size_t)(BK * 2);
    const size_t hstep = (size_t)HALF * K * 2;
    const size_t tstep = 2 * hstep;
    const size_t hstepB = G64 ? (size_t)32 * K * 2 : hstep;
    const size_t tstepA = GATHER ? 0 : tstep;
    const unsigned ldsw = (unsigned)wid * 1024u;
    const int aoff = lds_byte(wr * 64 + fr, fq * 8), boff = lds_byte(wc * 32 + fr, fq * 8);
#define PG8_SA(b, h) (((b) * 2 + (h)) * HTB)
#define PG8_SB(b, h) ((4 + (b) * 2 + (h)) * HTB)
#define PG8_STAGE(bufoff, gbase, voff) do { _Pragma("unroll") for (int _i = 0; _i < 2; ++_i) \
        __builtin_amdgcn_global_load_lds((const unsigned*)((const char*)(gbase) + (voff)[_i]), (PG8_LAS unsigned*)(lds + (bufoff) + ldsw + _i * 8192), 16, 0, 0); } while (0)
#define PG8_LDA(dst, b, h) do { if constexpr (FP8) { _Pragma("unroll") for (int m = 0; m < 4; ++m) dst##8[m] = __builtin_shufflevector(*(const PG8_LAS v4i_*)(lds + PG8_SA(b, h) + aoff + m * 2048), *(const PG8_LAS v4i_*)(lds + PG8_SA(b, h) + aoff + m * 2048 + 1024), 0, 1, 2, 3, 4, 5, 6, 7); } \
        else { _Pragma("unroll") for (int m = 0; m < 4; ++m) _Pragma("unroll") for (int k = 0; k < 2; ++k) dst[m][k] = *(const PG8_LAS bf16x8*)(lds + PG8_SA(b, h) + aoff + m * 2048 + k * 1024); } } while (0)
#define PG8_LDB(dst, b, h) do { if constexpr (FP8) { _Pragma("unroll") for (int n = 0; n < 2; ++n) dst##8[n] = __builtin_shufflevector(*(const PG8_LAS v4i_*)(lds + PG8_SB(b, h) + boff + n * 2048), *(const PG8_LAS v4i_*)(lds + PG8_SB(b, h) + boff + n * 2048 + 1024), 0, 1, 2, 3, 4, 5, 6, 7); } \
        else { _Pragma("unroll") for (int n = 0; n < 2; ++n) _Pragma("unroll") for (int k = 0; k < 2; ++k) dst[n][k] = *(const PG8_LAS bf16x8*)(lds + PG8_SB(b, h) + boff + n * 2048 + k * 1024); } } while (0)
#define PG8_MMA(ai, bj, At, Bt) do { __builtin_amdgcn_s_setprio(1); _Pragma("unroll") for (int m = 0; m < 4; ++m) _Pragma("unroll") for (int n = 0; n < 2; ++n) { \
        if constexpr (FP8) { acc[ai][bj][m][n] = __builtin_amdgcn_mfma_scale_f32_16x16x128_f8f6f4(Bt##8[n], At##8[m], acc[ai][bj][m][n], 0, 0, 0, 127, 0, 127); } \
        else { _Pragma("unroll") for (int k = 0; k < 2; ++k) acc[ai][bj][m][n] = __builtin_amdgcn_mfma_f32_16x16x32_bf16(Bt[n][k], At[m][k], acc[ai][bj][m][n], 0, 0, 0); } } \
        __builtin_amdgcn_s_setprio(0); } while (0)
#define PG8_STAGE_A(bufoff, gbase, h, nx) do { if constexpr (GATHER) { PG8_STAGE(bufoff, gbase, vC[h]); }   \
        else { PG8_STAGE(bufoff, (gbase) + (h) * hstep, voffA); } } while (0)
#define PG8_GLIST(dst, u_) do { _Pragma("unroll") for (int i_ = 0; i_ < 2; ++i_) { int R_, C_; stage_rc(tid * 16 + i_ * 8192, R_, C_);   \
        _Pragma("unroll") for (int h_ = 0; h_ < 2; ++h_) dst[h_][i_] = g.rowoff[(u_) * 256 + h_ * 128 + R_] + (unsigned)C_ * 2u; } } while (0)
#define PG8_WAIT_V(n) asm volatile("s_waitcnt vmcnt(" #n ")" ::: "memory")
#define PG8_WAIT_L(n) asm volatile("s_waitcnt lgkmcnt(" #n ")" ::: "memory")
#define PG8_BAR __builtin_amdgcn_s_barrier()
#define PG8_SCHED __builtin_amdgcn_sched_barrier(0)
    Unit cur, nxt; int ui = 0;
    if (!S.next(0, cur)) return;
    f32x4 acc[2][2][4][2];
#pragma unroll
    for (int a = 0; a < 2; ++a)
#pragma unroll
        for (int b = 0; b < 2; ++b)
#pragma unroll
            for (int m = 0; m < 4; ++m)
#pragma unroll
                for (int n = 0; n < 2; ++n) acc[a][b][m][n] = (f32x4){0.f, 0.f, 0.f, 0.f};
    bf16x8 At[4][2], B0[2][2], B1[2][2];
    typedef int v4i_ __attribute__((ext_vector_type(4))); typedef int v8i_ __attribute__((ext_vector_type(8)));
    v8i_ At8[4], B08[2], B18[2];
    const char* cA = (const char*)g.A + (size_t)cur.pm * tstepA; const char* cB = (const char*)g.Bt + (size_t)cur.pn * tstep;
    unsigned vC[2][2];
    if constexpr (GATHER) { PG8_GLIST(vC, 0); }
    S.a_ready(cur);
    if constexpr (SP2) {
        PG8_STAGE(PG8_SB(0, 0), cB, voffB); PG8_STAGE(PG8_SB(0, 1), cB + hstepB, voffB); PG8_STAGE_A(PG8_SA(0, 0), cA, 0, false); PG8_STAGE_A(PG8_SA(0, 1), cA, 1, false);
        if (wr == 1) PG8_BAR;
        PG8_WAIT_V(2); PG8_BAR;
        PG8_STAGE(PG8_SB(1, 0), cB + kstep, voffB); PG8_STAGE_A(PG8_SA(1, 0), cA + kstep, 0, false); PG8_STAGE(PG8_SB(1, 1), cB + hstepB + kstep, voffB);
        PG8_WAIT_V(6); PG8_BAR;
    } else {
        PG8_STAGE(PG8_SB(0, 0), cB, voffB); PG8_STAGE(PG8_SA(0, 0), cA, voffA); PG8_STAGE(PG8_SB(0, 1), cB + hstep, voffB); PG8_STAGE(PG8_SA(0, 1), cA + hstep, voffA);
        if (wr == 1) PG8_BAR;
        PG8_WAIT_V(4); PG8_BAR;
        PG8_STAGE(PG8_SB(1, 0), cB + kstep, voffB); PG8_STAGE(PG8_SA(1, 0), cA + kstep, voffA); PG8_STAGE(PG8_SB(1, 1), cB + hstep + kstep, voffB);
        PG8_WAIT_V(6); PG8_BAR;
    }
    for (;;) {
        const bool has_next = S.next(ui + 1, nxt);
        const char* nA = has_next ? (const char*)g.A + (size_t)nxt.pm * tstepA : cA; const char* nB = has_next ? (const char*)g.Bt + (size_t)nxt.pn * tstep : cB;
#pragma unroll 1
        for (int t = 0; t < nt; t += 2) {
            const bool last = (t == nt - 2);
            const char* a1 = cA + (size_t)(t + 1) * kstep;
            const char* a2 = last ? nA : cA + (size_t)(t + 2) * kstep; const char* b2 = last ? nB : cB + (size_t)(t + 2) * kstep;
            const char* a3 = a2 + kstep; const char* b3 = b2 + kstep;
            if (last && has_next) S.a_ready(nxt);
            if constexpr (SP2) {
            PG8_LDB(B0, 0, 0); PG8_LDB(B1, 0, 1); PG8_SCHED; PG8_LDA(At, 0, 0); PG8_STAGE_A(PG8_SA(1, 1), a1, 1, false);
            if constexpr (GATHER) { if (last && has_next) { PG8_GLIST(vC, ui + 1); } }
            PG8_WAIT_V(8); PG8_WAIT_L(0); PG8_BAR; PG8_MMA(0, 0, At, B0); PG8_MMA(0, 1, At, B1); PG8_BAR; PG8_SCHED;
            PG8_LDA(At, 0, 1); PG8_STAGE(PG8_SB(0, 0), b2, voffB); PG8_STAGE(PG8_SB(0, 1), b2 + hstepB, voffB); PG8_STAGE_A(PG8_SA(0, 0), a2, 0, last);
            PG8_WAIT_V(8); PG8_WAIT_L(0); PG8_BAR; PG8_MMA(1, 0, At, B0); PG8_MMA(1, 1, At, B1); PG8_BAR; PG8_SCHED;
            PG8_LDB(B0, 1, 0); PG8_LDB(B1, 1, 1); PG8_SCHED; PG8_LDA(At, 1, 0); PG8_STAGE_A(PG8_SA(0, 1), a2, 1, last);
            PG8_WAIT_V(8); PG8_WAIT_L(0); PG8_BAR; PG8_MMA(0, 0, At, B0); PG8_MMA(0, 1, At, B1); PG8_BAR; PG8_SCHED;
            PG8_LDA(At, 1, 1); PG8_STAGE(PG8_SB(1, 0), b3, voffB); PG8_STAGE(PG8_SB(1, 1), b3 + hstepB, voffB); PG8_STAGE_A(PG8_SA(1, 0), a3, 0, last);
            PG8_WAIT_V(8); PG8_WAIT_L(0); PG8_BAR; PG8_MMA(1, 0, At, B0); PG8_MMA(1, 1, At, B1); PG8_BAR; PG8_SCHED;
            } else {
            PG8_LDB(B0, 0, 0); PG8_SCHED; PG8_LDA(At, 0, 0); PG8_STAGE(PG8_SA(1, 1), a1 + hstep, voffA);
            PG8_WAIT_L(8); PG8_BAR; PG8_WAIT_L(0); PG8_MMA(0, 0, At, B0); PG8_BAR; PG8_SCHED;
            PG8_LDB(B1, 0, 1); PG8_STAGE(PG8_SB(0, 0), b2, voffB);
            PG8_BAR; PG8_WAIT_L(0); PG8_MMA(0, 1, At, B1); PG8_BAR;
            PG8_LDA(At, 0, 1); PG8_STAGE(PG8_SA(0, 0), a2, voffA);
            PG8_BAR; PG8_WAIT_L(0); PG8_MMA(1, 0, At, B0); PG8_BAR; PG8_SCHED;
            PG8_STAGE(PG8_SB(0, 1), b2 + hstep, voffB);
            PG8_WAIT_V(6); PG8_BAR; PG8_MMA(1, 1, At, B1); PG8_BAR;
            PG8_LDB(B0, 1, 0); PG8_SCHED; PG8_LDA(At, 1, 0); PG8_STAGE(PG8_SA(0, 1), a2 + hstep, voffA);
            PG8_WAIT_L(8); PG8_BAR; PG8_WAIT_L(0); PG8_MMA(0, 0, At, B0); PG8_BAR; PG8_SCHED;
            PG8_LDB(B1, 1, 1); PG8_STAGE(PG8_SB(1, 0), b3, voffB);
            PG8_BAR; PG8_WAIT_L(0); PG8_MMA(0, 1, At, B1); PG8_BAR;
            PG8_LDA(At, 1, 1); PG8_STAGE(PG8_SA(1, 0), a3, voffA);
            PG8_BAR; PG8_WAIT_L(0); PG8_MMA(1, 0, At, B0); PG8_BAR; PG8_SCHED;
            PG8_STAGE(PG8_SB(1, 1), b3 + hstep, voffB);
            PG8_WAIT_V(6); PG8_BAR; PG8_MMA(1, 1, At, B1); PG8_BAR;
            }
        }
        if constexpr (ALIGN_EPI) { if (wr == 0) PG8_BAR; }
        if constexpr (!Epi::AFTER_DRAIN) { E(acc, cur, wr, wc, fr, fq); S.done(cur); }
        if (!has_next) break;
#pragma unroll
        for (int a = 0; a < 2; ++a)
#pragma unroll
            for (int b = 0; b < 2; ++b)
#pragma unroll
                for (int m = 0; m < 4; ++m)
#pragma unroll
                    for (int n = 0; n < 2; ++n) acc[a][b][m][n] = (f32x4){0.f, 0.f, 0.f, 0.f};
        cur = nxt; cA = nA; cB = nB; ++ui;
        if constexpr (ALIGN_EPI) { if (wr == 1) PG8_BAR; }
    }
    PG8_WAIT_V(0);
    if constexpr (!ALIGN_EPI) { if (wr == 0) PG8_BAR; }
    PG8_BAR;
    if constexpr (Epi::AFTER_DRAIN) { E.fused(acc, cur, wr, wc, fr, fq, lds, wid, lane); S.done(cur); }
#undef PG8_SA
#undef PG8_SB
#undef PG8_STAGE
#undef PG8_STAGE_A
#undef PG8_GLIST
#undef PG8_LDA
#undef PG8_LDB
#undef PG8_MMA
#undef PG8_WAIT_V
#undef PG8_WAIT_L
#undef PG8_BAR
#undef PG8_SCHED
}
}
constexpr int NWAVES = 8;
constexpr int N_LAUNCHES = MK_N_LAUNCHES;
constexpr int PER_PHASE = 10;
constexpr int NTOK = 16384, DM = 1024, SEQ = 2048, NBATCH = 8, NHEAD = 4;
constexpr int INC = 3072;
constexpr int KOFF = 512, VOFF = 1024, CBOFF = 1536, CCOFF = 2048, CUOFF = 2560;
constexpr int NE = 32, DFF = 512, MAXT = 160, MAXSLOT = MAXT * 256;
constexpr float NORM_EPS = 1e-6f;
constexpr float QSCALE = 0.125f * 1.4426950408889634f;
constexpr float LAMBDA_INIT = 0.2f;
constexpr float WSCALE = MOE_FP8 ? 64.0f : 1.0f, XSCALE = MOE_FP8 ? 4.0f : 1.0f;
constexpr int MOE_ESZ = MOE_FP8 ? 1 : 2, DOWN_ESZ = MOE_FP8_DOWN ? 1 : 2;
constexpr float WSCALE_D = MOE_FP8_DOWN ? 64.0f : 1.0f;
constexpr size_t MiB = 1u << 20;
constexpr size_t WS_CTL = 0, CTL_ZERO_BYTES = 65536;
constexpr size_t WS_WIN = 1 * MiB, WS_WOUT = 7 * MiB, WS_WGU = 9 * MiB, WS_WD = 73 * MiB;
constexpr size_t WS_PROJ = 105 * MiB;
constexpr size_t WS_ACT = 105 * MiB;
constexpr size_t WS_Y2 = 145 * MiB;
constexpr size_t WS_MIX = 201 * MiB;
constexpr size_t WS_HN2 = 201 * MiB;
constexpr size_t WS_SMALL = 233 * MiB;
constexpr size_t SM_TOKE = 0, SM_TOKW = 131072, SM_SLOTT = 262144, SM_SLOTW = 262144 + 163840, SM_CCNT = 262144 + 2 * 163840, SM_TTAB = SM_CCNT + 32768, SM_WRH = SM_TTAB + 1024, SM_WRL = SM_WRH + 98304, SM_TOKRS = SM_WRL + 98304, SM_SLOTRS = SM_TOKRS + 65536;
constexpr size_t WS_CS = 235 * MiB;
constexpr size_t WS_END = 236 * MiB;
static_assert(WS_ACT + (size_t)MAXSLOT * 512 * 2 <= WS_Y2 && WS_Y2 + (size_t)NTOK * 2 * 1024 * 2 <= WS_SMALL && WS_PROJ + (size_t)NTOK * INC * 2 <= WS_MIX && WS_MIX + (size_t)NTOK * DM * 2 <= WS_SMALL && SM_SLOTRS + 163840 <= 2 * MiB, "d_ws map");
constexpr int CW_TMO = 0, CW_BAR = 4096;
constexpr int RING_OFF = 0, RING_BYTES = 131072;
constexpr int TAB_OFF = RING_BYTES;
constexpr int LIST_OFF = TAB_OFF + 1024, MAXLIST = 8;
constexpr int LDSCTL_OFF = LIST_OFF + MAXLIST * 1024, MISC_OFF = LDSCTL_OFF + 320;
constexpr int LDS_BYTES = 147456;
static_assert(MISC_OFF + 128 <= LDS_BYTES, "LDS map");
#define GAS __attribute__((address_space(1)))
#define LAS __attribute__((address_space(3)))
typedef unsigned short bf16;
typedef unsigned v4u __attribute__((ext_vector_type(4)));
typedef float f32x4 __attribute__((ext_vector_type(4)));
typedef short bf16x8 __attribute__((ext_vector_type(8)));
typedef GAS unsigned gu32;
typedef GAS unsigned long long gu64;
#define RLX_AGENT __ATOMIC_RELAXED, __HIP_MEMORY_SCOPE_AGENT
#define LDS_WAIT() asm volatile("s_waitcnt lgkmcnt(0)" ::: "memory")
#define VM_WAIT() asm volatile("s_waitcnt vmcnt(0)" ::: "memory")
__device__ __forceinline__ unsigned long long rt() { return __builtin_amdgcn_s_memrealtime(); }
__device__ __forceinline__ unsigned f2bf(float f) { unsigned u = __builtin_bit_cast(unsigned, f); return (u + 0x7fffu + ((u >> 16) & 1u)) >> 16; }
__device__ __forceinline__ unsigned pk4_fp8(float a, float b, float c, float d) { int w = 0; w = __builtin_amdgcn_cvt_pk_fp8_f32(a, b, w, false); w = __builtin_amdgcn_cvt_pk_fp8_f32(c, d, w, true); return (unsigned)w; }
typedef float f32x2_t __attribute__((ext_vector_type(2))); typedef __bf16 bf16x2_t __attribute__((ext_vector_type(2)));
__device__ __forceinline__ unsigned pk2(float lo, float hi) { const f32x2_t v = {lo, hi}; const bf16x2_t b = __builtin_convertvector(v, bf16x2_t); return __builtin_bit_cast(unsigned, b); }

#define XB_TMO      128
#define XB_XCNT(j)  (256  + 64 * (j))
#define XB_XSUB(j)  (1280 + 64 * (j))
#define XB_XGEN(j)  (2304 + 64 * (j))
#define XB_TOP      3328
#define XB_TOPGEN   3392
#define XCD_BAR_WORDS 3456
#define XB_SPIN_CAP (1u << 18)

__device__ __forceinline__ unsigned xb_ld(unsigned* p)              { return __hip_atomic_load(p, __ATOMIC_RELAXED, __HIP_MEMORY_SCOPE_AGENT); }
__device__ __forceinline__ unsigned xb_add(unsigned* p, unsigned v) { return __hip_atomic_fetch_add(p, v, __ATOMIC_RELAXED, __HIP_MEMORY_SCOPE_AGENT); }
__device__ __forceinline__ unsigned xb_xcc_id() { return (unsigned)__builtin_amdgcn_s_getreg((3 << 11) | 20) & 0xFu; }
#define XB_SPIN(cond, bar) do { unsigned _sp = 0; while (cond) { __builtin_amdgcn_s_sleep(1); \
    if ((++_sp & 255u) == 0u) { if (xb_ld(&(bar)[XB_TMO])) break; if (_sp > XB_SPIN_CAP) { atomicAdd(&(bar)[XB_TMO], 1u); break; } } } } while (0)

struct XcdBarrier {
    unsigned* bar; unsigned x;
    volatile LAS unsigned* st;
};

__device__ __forceinline__ XcdBarrier xcd_barrier_post(unsigned* bar, volatile LAS unsigned* st) {
    XcdBarrier b; b.bar = bar; b.x = xb_xcc_id(); b.st = st;
    if (threadIdx.x == 0) (void)xb_add(&bar[XB_XCNT(b.x)], 1u);
    return b;
}
__device__ __forceinline__ void xcd_barrier_complete(unsigned* bar, unsigned x, unsigned& nloc, unsigned& nx) {
    const unsigned G = gridDim.x * gridDim.y * gridDim.z;
    unsigned sum, cnt, mine, sp = 0u;
    for (;;) {
        sum = 0u; cnt = 0u; mine = 0u;
#pragma unroll
        for (unsigned j = 0; j < 16; ++j) { const unsigned c = xb_ld(&bar[XB_XCNT(j)]); sum += c; cnt += (c > 0u) ? 1u : 0u; mine = (j == x) ? c : mine; }
        if (sum == G) break;
        __builtin_amdgcn_s_sleep(1);
        if ((++sp & 255u) == 0u) { if (xb_ld(&bar[XB_TMO])) break; if (sp > XB_SPIN_CAP) { atomicAdd(&bar[XB_TMO], 1u); break; } }
    }
    nloc = mine > 0u ? mine : 1u; nx = cnt > 0u ? cnt : 1u;
}

__device__ __forceinline__ void xcd_barrier(const XcdBarrier& b, const bool t0  ) {
    asm volatile("s_waitcnt vmcnt(0)" ::: "memory");
    __syncthreads();
    if (t0) {
        unsigned* bar = b.bar;
        __builtin_amdgcn_s_waitcnt(0);
        unsigned nloc = b.st[0], nx = b.st[1];
        if (nloc == 0u) { xcd_barrier_complete(bar, b.x, nloc, nx); b.st[0] = nloc; b.st[1] = nx; }
        const unsigned old = xb_add(&bar[XB_XSUB(b.x)], 1u);
        const unsigned gen = old / nloc;
        if (old + 1u == (gen + 1u) * nloc) {
            __builtin_amdgcn_fence(__ATOMIC_RELEASE, "agent");
            asm volatile("s_waitcnt vmcnt(0)" ::: "memory");
            const unsigned og = xb_add(&bar[XB_TOP], 1u);
            const unsigned tg = og / nx;
            if (og + 1u == (tg + 1u) * nx) xb_add(&bar[XB_TOPGEN], 1u);
            else XB_SPIN(xb_ld(&bar[XB_TOPGEN]) == tg, bar);
            __builtin_amdgcn_fence(__ATOMIC_ACQUIRE, "agent");
            xb_add(&bar[XB_XGEN(b.x)], 1u);
            asm volatile("s_waitcnt vmcnt(0)" ::: "memory");
        } else {
            XB_SPIN(xb_ld(&bar[XB_XGEN(b.x)]) == gen, bar);
            __builtin_amdgcn_fence(__ATOMIC_ACQUIRE, "agent");
            asm volatile("s_waitcnt vmcnt(0)" ::: "memory");
        }
    }
    __syncthreads();
}
typedef short s16x4 __attribute__((ext_vector_type(4)));
typedef float f32x16 __attribute__((ext_vector_type(16)));
typedef unsigned v2u __attribute__((ext_vector_type(2)));
struct Frame {
    LAS unsigned char* lds;
    volatile LAS unsigned* MISC;
    gu32* ctl;
    int tid, lane, wave;
    int vcu, G;
    const float* x; const int* pos; const float *g_attn, *w_in, *g_q, *g_k, *lq1, *lk1, *lq2, *lk2, *g_sub, *conv_w, *g_conv, *w_out, *g_ffn, *w_gr, *w_er, *w_gate, *w_up, *w_down;
    float* out;
    bf16 *Wt_in, *Wt_out, *Wt_gu, *Wt_d, *Wr_hi, *Wr_lo;
    bf16 *HN, *PROJ, *MIX, *HN2, *ACT, *Y2;
    float* cs;
    int* tok_e; float* tok_w; float* tok_rs; int* slot_tok; float* slot_w; float* slot_rs; int* ccnt; int* ttab;
};
__device__ __forceinline__ float wave_sum(float v) {
#pragma unroll
    for (int o = 1; o < 64; o <<= 1) v += __shfl_xor(v, o);
    return v;
}
__device__ __forceinline__ float wave_max(float v) {
#pragma unroll
    for (int o = 1; o < 64; o <<= 1) v = fmaxf(v, __shfl_xor(v, o));
    return v;
}
__device__ __forceinline__ float bf2f(unsigned short b) { return __builtin_bit_cast(float, (unsigned)b << 16); }
__device__ __forceinline__ float bflo(unsigned w) { return __builtin_bit_cast(float, w << 16); }
__device__ __forceinline__ float bfhi(unsigned w) { return __builtin_bit_cast(float, w & 0xffff0000u); }

__device__ __forceinline__ void p0_transpose_item(const float* W, int K, int N, bf16* WT, int k0, int n0, int dst_row0, LAS float* scr, int lane) {
#pragma unroll 8
    for (int i = 0; i < 32; ++i) { const int kk = 2 * i + (lane >> 5); scr[kk * 33 + (lane & 31)] = W[(size_t)(k0 + kk) * N + n0 + (lane & 31)]; }
    LDS_WAIT(); asm volatile("" ::: "memory");
    const int c = lane & 7;
#pragma unroll
    for (int j = 0; j < 4; ++j) { const int n = (lane >> 3) + 8 * j; const LAS float* s = scr + (8 * c) * 33 + n;
        v4u o; o.x = pk2(s[0 * 33], s[1 * 33]); o.y = pk2(s[2 * 33], s[3 * 33]); o.z = pk2(s[4 * 33], s[5 * 33]); o.w = pk2(s[6 * 33], s[7 * 33]);
        *(GAS v4u*)(WT + (size_t)(dst_row0 + n) * K + k0 + 8 * c) = o; }
    LDS_WAIT(); asm volatile("" ::: "memory");
}
__device__ __forceinline__ void rms_row_to_bf16(const float* xrow, const float* gain, bf16* orow, int lane) {
    const GAS f32x4* xr = (const GAS f32x4*)xrow + lane; const GAS f32x4* gr = (const GAS f32x4*)gain + lane;
    f32x4 v[4]; float s = 0.f;
#pragma unroll
    for (int j = 0; j < 4; ++j) { v[j] = xr[64 * j]; s += (v[j].x * v[j].x + v[j].y * v[j].y) + (v[j].z * v[j].z + v[j].w * v[j].w); }
    const float rstd = 1.f / sqrtf(wave_sum(s) * (1.f / DM) + NORM_EPS);
    GAS unsigned long long* o8 = (GAS unsigned long long*)orow + lane;
#pragma unroll
    for (int j = 0; j < 4; ++j) { const f32x4 g = gr[64 * j]; o8[64 * j] = (unsigned long long)pk2(v[j].x * rstd * g.x, v[j].y * rstd * g.y) | ((unsigned long long)pk2(v[j].z * rstd * g.z, v[j].w * rstd * g.w) << 32); }
}
__device__ __forceinline__ void p0_prologue(Frame& F) {
    LAS float* scr = (LAS float*)(F.lds + RING_OFF + F.wave * 16384);
    const int gw = F.vcu * NWAVES + F.wave, NGW = F.G * NWAVES;
    constexpr int I_IN = (DM / 64) * (INC / 32), I_OUT = (DM / 64) * (DM / 32);
    constexpr int NITEMS = I_IN + I_OUT;
    for (int it = gw; it < NITEMS; it += NGW) {
        int r = it;
        if (r < I_IN) { const int kb = r / (INC / 32), nb = r % (INC / 32); p0_transpose_item(F.w_in, DM, INC, F.Wt_in, 64 * kb, 32 * nb, 32 * nb, scr, F.lane); continue; } r -= I_IN;
        { const int kb = r / (DM / 32), nb = r % (DM / 32); p0_transpose_item(F.w_out, DM, DM, F.Wt_out, 64 * kb, 32 * nb, 32 * nb, scr, F.lane); }
    }
    for (int m = gw; m < NTOK; m += NGW) rms_row_to_bf16(F.x + (size_t)m * DM, F.g_attn, F.HN + (size_t)m * DM, F.lane);
    for (int i = gw * 64 + F.lane; i < MAXSLOT; i += NGW * 64) F.slot_tok[i] = -1;
    for (int i = gw * 64 + F.lane; i < NTOK * 8; i += NGW * 64) { const int t = i >> 3, j = i & 7;
        const float fr = exp2f(-(float)j * (18.931568569324174f / 8.0f)); const float ang = (float)F.pos[t] * fr;
        const float rev = __builtin_amdgcn_fractf(ang * 0.15915494309189535f); F.cs[t * 16 + j] = __builtin_amdgcn_cosf(rev); F.cs[t * 16 + 8 + j] = __builtin_amdgcn_sinf(rev); }
    for (int i = gw * 64 + F.lane; i < 48 * DM; i += NGW * 64) { const int cidx = i >> 10, k = i & (DM - 1); float w = 0.f;
        if (cidx < 4) w = F.w_gr[k * 4 + cidx] * F.g_ffn[k]; else if (cidx < 36) { const int e = cidx - 4; w = F.w_er[((size_t)(e >> 3) * DM + k) * 8 + (e & 7)] * F.g_ffn[k]; }
        const unsigned hb = f2bf(w); const float hf = __builtin_bit_cast(float, hb << 16); F.Wr_hi[i] = (bf16)hb; F.Wr_lo[i] = (bf16)f2bf(w - hf); }
}

__device__ __forceinline__ void p2_conv(Frame& F) {
    const int gw = F.vcu * NWAVES + F.wave, NGW = F.G * NWAVES, lane = F.lane;
    float cw0[8], cw1[8], cw2[8], gc[8];
#pragma unroll
    for (int j = 0; j < 8; ++j) { cw0[j] = F.conv_w[lane * 8 + j]; cw1[j] = F.conv_w[512 + lane * 8 + j]; cw2[j] = F.conv_w[1024 + lane * 8 + j]; gc[j] = F.g_conv[lane * 8 + j]; }
    for (int t = gw; t < NTOK; t += NGW) {
        bf16* row = F.PROJ + (size_t)t * INC;
        {
            const int ts = t & (SEQ - 1);
            float z[8];
#pragma unroll
            for (int j = 0; j < 8; ++j) z[j] = 0.f;
#pragma unroll
            for (int d = 0; d < 3; ++d) {
                if (ts - d >= 0) {
                    const bf16* rr = row - (size_t)d * INC;
                    const v4u c = *((const GAS v4u*)(rr + CCOFF) + lane), u = *((const GAS v4u*)(rr + CUOFF) + lane);
                    float y[8];
                    y[0] = bflo(c.x) * bflo(u.x); y[1] = bfhi(c.x) * bfhi(u.x); y[2] = bflo(c.y) * bflo(u.y); y[3] = bfhi(c.y) * bfhi(u.y);
                    y[4] = bflo(c.z) * bflo(u.z); y[5] = bfhi(c.z) * bfhi(u.z); y[6] = bflo(c.w) * bflo(u.w); y[7] = bfhi(c.w) * bfhi(u.w);
#pragma unroll
                    for (int j = 0; j < 8; ++j) z[j] += (d == 0 ? cw2[j] : (d == 1 ? cw1[j] : cw0[j])) * y[j];
                }
            }
            const v4u b = *((const GAS v4u*)(row + CBOFF) + lane);
            float v[8];
            v[0] = bflo(b.x) * z[0]; v[1] = bfhi(b.x) * z[1]; v[2] = bflo(b.y) * z[2]; v[3] = bfhi(b.y) * z[3];
            v[4] = bflo(b.z) * z[4]; v[5] = bfhi(b.z) * z[5]; v[6] = bflo(b.w) * z[6]; v[7] = bfhi(b.w) * z[7];
            float ss = 0.f;
#pragma unroll
            for (int j = 0; j < 8; ++j) ss += v[j] * v[j];
            const float rstd = 1.f / sqrtf(wave_sum(ss) * (1.f / 512.f) + NORM_EPS);
            v4u r; r.x = pk2(v[0] * rstd * gc[0], v[1] * rstd * gc[1]); r.y = pk2(v[2] * rstd * gc[2], v[3] * rstd * gc[3]);
            r.z = pk2(v[4] * rstd * gc[4], v[5] * rstd * gc[5]); r.w = pk2(v[6] * rstd * gc[6], v[7] * rstd * gc[7]);
            *((GAS v4u*)(F.MIX + (size_t)t * DM + 512) + lane) = r;
        }
    }
}
__device__ __forceinline__ float lambda_full(const Frame& F) {
    const int l = F.lane; const float a = wave_sum(F.lq1[l] * F.lk1[l]), b = wave_sum(F.lq2[l] * F.lk2[l]);
    return expf(a) - expf(b) + LAMBDA_INIT;
}
#if NAIVE_ATTN
#define NAIVE_DOT(kr, s0, s1) do { _Pragma("unroll") for (int c_ = 0; c_ < 16; ++c_) { const v4u w_ = *((const GAS v4u*)(kr) + c_); const LAS float* q_ = qs + 8 * c_; \
    const float d_ = q_[0] * bflo(w_.x) + q_[1] * bfhi(w_.x) + q_[2] * bflo(w_.y) + q_[3] * bfhi(w_.y) + q_[4] * bflo(w_.z) + q_[5] * bfhi(w_.z) + q_[6] * bflo(w_.w) + q_[7] * bfhi(w_.w); \
    if (c_ < 8) s0 += d_; else s1 += d_; } } while (0)
__device__ __forceinline__ void p3_attention(Frame& F) {
    const int gw = F.vcu * NWAVES + F.wave, NGW = F.G * NWAVES, lane = F.lane;
    const float lam = lambda_full(F);
    LAS float* qs = (LAS float*)(F.lds + RING_OFF) + F.wave * 256;
    LAS float* af = qs + 128;
    for (int R = gw; R < NBATCH * NHEAD * SEQ; R += NGW) {
        const int bh = R / SEQ, q = R % SEQ, b = bh / NHEAD, h = bh % NHEAD;
        const bf16* base = F.PROJ + (size_t)b * SEQ * INC + h * 128;
        qs[lane] = bf2f(base[(size_t)q * INC + lane]); qs[64 + lane] = bf2f(base[(size_t)q * INC + 64 + lane]);
        LDS_WAIT(); asm volatile("" ::: "memory");
        float m0 = -INFINITY, l0 = 0.f, m1 = -INFINITY, l1 = 0.f;
        for (int j = lane; j <= q; j += 64) {
            const bf16* kr = base + (size_t)j * INC + KOFF; float s0 = 0.f, s1 = 0.f;
            NAIVE_DOT(kr, s0, s1);
            { const float mn = fmaxf(m0, s0); l0 = l0 * exp2f(m0 - mn) + exp2f(s0 - mn); m0 = mn; }
            { const float mn = fmaxf(m1, s1); l1 = l1 * exp2f(m1 - mn) + exp2f(s1 - mn); m1 = mn; }
        }
        const float M0 = wave_max(m0), M1 = wave_max(m1);
        const float L0 = wave_sum(l0 * exp2f(m0 - M0)), L1 = wave_sum(l1 * exp2f(m1 - M1));
        float o0 = 0.f, o1 = 0.f;
        for (int j0 = 0; j0 <= q; j0 += 64) {
            const int j = j0 + lane; float a = 0.f;
            if (j <= q) { const bf16* kr = base + (size_t)j * INC + KOFF; float s0 = 0.f, s1 = 0.f;
                NAIVE_DOT(kr, s0, s1);
                a = exp2f(s0 - M0) / L0 - lam * exp2f(s1 - M1) / L1; }
            af[lane] = a; LDS_WAIT(); asm volatile("" ::: "memory");
            const int nj = (q - j0 + 1) < 64 ? (q - j0 + 1) : 64;
            for (int jj = 0; jj < nj; ++jj) { const unsigned w = *(const unsigned*)(base + (size_t)(j0 + jj) * INC + VOFF + 2 * lane); const float aj = af[jj]; o0 += aj * bflo(w); o1 += aj * bfhi(w); }
            LDS_WAIT(); asm volatile("" ::: "memory");
        }
        const float ss = wave_sum(o0 * o0 + o1 * o1); const float rstd = 1.f / sqrtf(ss * (1.f / 128.f) + NORM_EPS);
        const float g0 = F.g_sub[2 * lane], g1 = F.g_sub[2 * lane + 1];
        *(unsigned*)(F.MIX + (size_t)(b * SEQ + q) * DM + h * 128 + 2 * lane) = pk2(o0 * rstd * g0 * (1.f - LAMBDA_INIT), o1 * rstd * g1 * (1.f - LAMBDA_INIT));
    }
}
#else
namespace att {
constexpr int KT_BYTES = 8192, KSTAGE = 16384, VSTAGE = 16384, VRING = 2 * KSTAGE, CVSCR = VRING + 3 * VSTAGE, QSTORE = CVSCR + 8 * 4096;
__device__ __forceinline__ s16x4 vtr(const LAS unsigned char* p) { return __builtin_bit_cast(s16x4, __builtin_amdgcn_ds_read_tr16_b64_v4i16((LAS s16x4*)p)); }
}
struct CvPiece { const float* src; unsigned char* dst; int N, K, fp8; float scale; };
constexpr int CV_PER_EXPERT = 192, CV_TOTAL = NE * CV_PER_EXPERT;
__device__ __forceinline__ CvPiece cv_decode(const Frame& F, int sp, int w) {
    const int e = sp / CV_PER_EXPERT; int r = sp - e * CV_PER_EXPERT; CvPiece c;
    if (r < 128) { const int up = r >= 64; r &= 63; const int nb = (r >> 5) * 8 + w, kb = r & 31, n0 = 32 * nb, k0 = 32 * kb;
        c.src = (up ? F.w_up : F.w_gate) + (size_t)e * DM * DFF + (size_t)k0 * DFF + n0; c.N = DFF; c.K = DM;
        c.dst = (unsigned char*)F.Wt_gu + ((size_t)(e * 1024 + (n0 >> 7) * 256 + up * 128 + (n0 & 127)) * DM + k0) * MOE_ESZ; c.fp8 = MOE_FP8; c.scale = WSCALE; }
    else { r -= 128; const int nb = (r >> 4) * 8 + w, kb = r & 15, n0 = 32 * nb, k0 = 32 * kb;
        c.src = F.w_down + (size_t)e * DFF * DM + (size_t)k0 * DM + n0; c.N = DM; c.K = DFF;
        c.dst = (unsigned char*)F.Wt_d + ((size_t)(e * 1024 + n0) * DFF + k0) * DOWN_ESZ; c.fp8 = MOE_FP8_DOWN; c.scale = WSCALE_D; }
    return c;
}
__device__ __forceinline__ void cv_issue(const CvPiece& c, int lane, LAS float* scr) {
    const char* sb = (const char*)c.src; asm volatile("" : "+s"(sb));
#pragma unroll
    for (int i = 0; i < 4; ++i) { const unsigned voff = (unsigned)(((8 * i + (lane >> 3)) * c.N + (((lane & 7) ^ (2 * i)) << 2)) * 4);
        __builtin_amdgcn_global_load_lds((const unsigned*)(sb + voff), (LAS unsigned*)((LAS unsigned char*)scr + i * 1024), 16, 0, 0); }
}
__device__ __forceinline__ void cv_finish(const CvPiece& c, int lane, LAS float* scr) {
#pragma unroll
    for (int j = 0; j < 2; ++j) { const int task = lane + 64 * j, n = task >> 2, cc = task & 3; const LAS float* s = (const LAS float*)((const LAS unsigned char*)scr + (8 * cc) * 128 + (((n >> 2) ^ (2 * cc)) << 4) + (n & 3) * 4);
        if (c.fp8) { const float sc = c.scale; v2u o; o.x = pk4_fp8(s[0 * 32] * sc, s[1 * 32] * sc, s[2 * 32] * sc, s[3 * 32] * sc); o.y = pk4_fp8(s[4 * 32] * sc, s[5 * 32] * sc, s[6 * 32] * sc, s[7 * 32] * sc);
            *(GAS v2u*)(c.dst + (size_t)n * c.K + 8 * cc) = o; }
        else { v4u o; o.x = pk2(s[0 * 32], s[1 * 32]); o.y = pk2(s[2 * 32], s[3 * 32]); o.z = pk2(s[4 * 32], s[5 * 32]); o.w = pk2(s[6 * 32], s[7 * 32]);
            *(GAS v4u*)(c.dst + ((size_t)n * c.K + 8 * cc) * 2) = o; } }
    LDS_WAIT(); asm volatile("" ::: "memory");
}
__device__ __forceinline__ void p3_attention(Frame& F) {
    using namespace att;
    const int tid = F.tid, lane = F.lane, wid = F.wave, r32 = lane & 31, hi = lane >> 5;
    const int map = wid >> 2, wq = wid & 3;
    const float lam = lambda_full(F);
    LAS unsigned char* L = F.lds + RING_OFF;
    const int krow = wid * 8 + (lane >> 3), kch = (lane & 7) ^ ((krow >> 1) & 7);
    const int vrow0 = wid * 4 + (lane >> 4), vrow1 = vrow0 + 32;
    const int vch0 = (lane & 15) ^ (((vrow0 & 3) << 2) | ((vrow0 >> 2) & 3)), vch1 = (lane & 15) ^ (((vrow1 & 3) << 2) | ((vrow1 >> 2) & 3));
    const unsigned kvoff = (unsigned)((krow * INC + KOFF + kch * 8) * 2), vvoff0 = (unsigned)((vrow0 * INC + VOFF + vch0 * 8) * 2);
    (void)vrow1; (void)vch1;
    const unsigned ksw = (unsigned)((r32 >> 1) & 7), kb0 = (unsigned)(map * KT_BYTES + r32 * 128) + (((unsigned)hi ^ (ksw & 1u)) << 4), ks6 = (ksw & 6u) << 4;
#define KFRAG_OFF(d0) (kb0 + ((32u * (d0)) ^ ks6))
    const int vq = (lane & 15) >> 2, vp = lane & 3, vblk = (lane >> 4) & 1;
    unsigned vlow[2];
#pragma unroll
    for (int t = 0; t < 2; ++t) vlow[t] = (unsigned)(256 * (8 * t + 4 * hi + vq) + 16 * ((2 * vblk + (vp >> 1)) ^ ((2 * t + hi) & 3)) + 8 * (vp & 1));
    const unsigned vq6 = (unsigned)vq << 6;
#define VCX(c) ((64u * (c)) ^ vq6)

    LAS float* cvscr = (LAS float*)(L + CVSCR) + wid * 1024;
    int cvp, cvend; { const int per = (CV_TOTAL + F.G - 1) / F.G; cvp = F.vcu * per; cvend = cvp + per < CV_TOTAL ? cvp + per : CV_TOTAL; if (cvp > cvend) cvp = cvend; }
    CvPiece cvc;
    if (cvp < cvend) { cvc = cv_decode(F, cvp, wid); cv_issue(cvc, lane, cvscr); }
#pragma unroll 1
    for (int rep_ = 0; rep_ < 1 + DUP(3); ++rep_)
    for (int pr = F.vcu; pr < 256; pr += F.G) {
      const int bh = pr >> 3, b = bh >> 2, h = bh & 3, s8 = pr & 7;
#pragma unroll 1
      for (int half = 0; half < 2; ++half) {
        const int qb = half ? 15 - s8 : s8;
        const int NT = 2 * (qb + 1);
        const int q0w = qb * 128 + wq * 32;
        const bf16* Pb = F.PROJ + (size_t)b * SEQ * INC + h * 128;
        bf16x8 qf[4];
        unsigned qvoff_now; { int r32q = r32, hiq = hi; asm volatile("" : "+v"(r32q), "+v"(hiq)); qvoff_now = (unsigned)((r32q * INC + hiq * 8) * 2); }
#pragma unroll
        for (int d0 = 0; d0 < 4; ++d0) qf[d0] = *(const bf16x8*)((const char*)Pb + ((size_t)q0w * INC + map * 64 + d0 * 16) * 2 + qvoff_now);
        f32x16 o[4];
#pragma unroll
        for (int c = 0; c < 4; ++c)
#pragma unroll
            for (int r = 0; r < 16; ++r) o[c][r] = 0.f;
        float mrow = -INFINITY, lrow = 0.f;
        const char* Pbc = (const char*)Pb;
#define ATT_DMA(t, ks, vs) do { const char* tb_ = Pbc + (size_t)(t) * 64 * INC * 2; asm volatile("" : "+s"(tb_)); LAS unsigned char* kb_ = L + (ks) * KSTAGE; LAS unsigned char* vb_ = L + VRING + (vs) * VSTAGE;   \
        __builtin_amdgcn_global_load_lds((const unsigned*)(tb_ + kvoff), (LAS unsigned*)(kb_ + wid * 1024), 16, 0, 0); \
        __builtin_amdgcn_global_load_lds((const unsigned*)(tb_ + 128 + kvoff), (LAS unsigned*)(kb_ + KT_BYTES + wid * 1024), 16, 0, 0); \
        __builtin_amdgcn_global_load_lds((const unsigned*)(tb_ + vvoff0), (LAS unsigned*)(vb_ + wid * 1024), 16, 0, 0); \
        __builtin_amdgcn_global_load_lds((const unsigned*)(tb_ + 32 * INC * 2 + vvoff0), (LAS unsigned*)(vb_ + 8192 + wid * 1024), 16, 0, 0); } while (0)
#define ATT_STEP_BAR() do { asm volatile("s_waitcnt lgkmcnt(0)" ::: "memory"); __builtin_amdgcn_s_barrier(); asm volatile("" ::: "memory"); } while (0)
#define ATT_QKSM1(kfb, kvb) do { f32x16 p; \
            _Pragma("unroll") for (int r = 0; r < 16; ++r) p[r] = 0.f; \
            _Pragma("unroll") for (int d0 = 0; d0 < 4; ++d0) { const bf16x8 kf = *(const LAS bf16x8*)((kfb) + KFRAG_OFF(d0)); p = __builtin_amdgcn_mfma_f32_32x32x16_bf16(kf, qf[d0], p, 0, 0, 0); } \
            if ((kvb) + 31 > q0w) { asm volatile("" ::: "memory"); const int qabs = q0w + r32; \
                _Pragma("unroll") for (int r = 0; r < 16; ++r) { const int kv = (kvb) + (r & 3) + 8 * (r >> 2) + 4 * hi; if (kv > qabs) p[r] = -INFINITY; } } \
            float rm = p[0]; \
            _Pragma("unroll") for (int r = 1; r < 16; ++r) rm = fmaxf(rm, p[r]); \
            rm = fmaxf(rm, __shfl_xor(rm, 32)); \
            const float mnew = fmaxf(mrow, rm); const float alpha = __builtin_amdgcn_exp2f(mrow - mnew); mrow = mnew; \
            float ls = 0.f; \
            _Pragma("unroll") for (int r = 0; r < 16; ++r) { const float e = __builtin_amdgcn_exp2f(p[r] - mnew); p[r] = e; ls += e; } \
            lrow = lrow * alpha + ls; \
            if (__any(alpha != 1.0f)) { _Pragma("unroll") for (int c = 0; c < 4; ++c) _Pragma("unroll") for (int r = 0; r < 16; ++r) o[c][r] *= alpha; } \
            _Pragma("unroll") for (int s = 0; s < 2; ++s) { v4u pw; pw.x = pk2(p[8 * s + 0], p[8 * s + 1]); pw.y = pk2(p[8 * s + 2], p[8 * s + 3]); \
                pw.z = pk2(p[8 * s + 4], p[8 * s + 5]); pw.w = pk2(p[8 * s + 6], p[8 * s + 7]); pf2[s] = pw; } } while (0)
#define ATT_VLD(dst, vrb, s) do { const LAS unsigned char* vb_ = (vrb) + 256 * (16 * (s)); _Pragma("unroll") for (int c = 0; c < 4; ++c) { const s16x4 lo = vtr(vb_ + (vlow[0] + VCX(c))), hh = vtr(vb_ + (vlow[1] + VCX(c))); \
            dst[c] = (bf16x8){lo[0], lo[1], lo[2], lo[3], hh[0], hh[1], hh[2], hh[3]}; } } while (0)
#define ATT_VMM(src, s) do { const bf16x8 pfr = __builtin_bit_cast(bf16x8, pf2[s]); _Pragma("unroll") for (int c = 0; c < 4; ++c) o[c] = __builtin_amdgcn_mfma_f32_32x32x16_bf16(src[c], pfr, o[c], 0, 0, 0); } while (0)
#define ATT_PV1(vrb) do { bf16x8 va_[4], vb2_[4]; __builtin_amdgcn_sched_barrier(0); ATT_VLD(va_, vrb, 0); __builtin_amdgcn_sched_barrier(0); \
            ATT_VLD(vb2_, vrb, 1); ATT_VMM(va_, 0); __builtin_amdgcn_sched_barrier(0); ATT_VMM(vb2_, 1); __builtin_amdgcn_sched_barrier(0); } while (0)
        ATT_DMA(0, 0, 0);
        asm volatile("s_waitcnt vmcnt(0)" ::: "memory");
        ATT_STEP_BAR();
        v4u pf2[2]; bool pend = false;
        int kst = 0, vst = 0, vst_prev = 2;
#pragma unroll 1
        for (int t = 0; t < NT; ++t) {
            const int vst_next = vst == 2 ? 0 : vst + 1;
            if (t + 1 < NT) ATT_DMA(t + 1, kst ^ 1, vst_next);
            const int kv0 = t * 64;
            const LAS unsigned char* ksb = L + kst * KSTAGE; const LAS unsigned char* vcur = L + VRING + vst * VSTAGE; const LAS unsigned char* vprv = L + VRING + vst_prev * VSTAGE;
#pragma unroll
            for (int kb = 0; kb < 2; ++kb) {
                const bool act = kv0 + 32 * kb <= q0w + 31;
                if (map == 0 || !ATT_STAGGER) { if (act) { ATT_QKSM1(ksb + kb * 4096, kv0 + 32 * kb); ATT_PV1(vcur + kb * 8192); } }
                else { if (pend) { if (kb == 0) { ATT_PV1(vprv + 8192); } else { ATT_PV1(vcur); } } if (act) { ATT_QKSM1(ksb + kb * 4096, kv0 + 32 * kb); } pend = act; }
            }
            asm volatile("s_waitcnt vmcnt(0)" ::: "memory");
            if (cvp < cvend) { cv_finish(cvc, lane, cvscr); ++cvp; if (cvp < cvend) { cvc = cv_decode(F, cvp, wid); cv_issue(cvc, lane, cvscr); } }
            ATT_STEP_BAR();
            kst ^= 1; vst_prev = vst; vst = vst_next;
        }
        if (ATT_STAGGER && map == 1 && pend) { ATT_PV1(L + VRING + vst_prev * VSTAGE + 8192); }
        __syncthreads();
#undef ATT_DMA
#undef ATT_STEP_BAR
#undef ATT_QKSM1
#undef ATT_PV1
#undef ATT_VLD
#undef ATT_VMM
        lrow += __shfl_xor(lrow, 32);
        const float inv = 1.0f / lrow;
        int lanee = lane; asm volatile("" : "+v"(lanee));
        LAS float* xb = (LAS float*)L + wq * 4096 + lanee;
        if (map == 1) {
#pragma unroll
            for (int c = 0; c < 4; ++c)
#pragma unroll
                for (int r = 0; r < 16; ++r) xb[(c * 16 + r) * 64] = o[c][r] * inv;
        }
        __syncthreads();
        if (map == 0) {
            int r32e = r32, hie = hi; asm volatile("" : "+v"(r32e), "+v"(hie));
            float ss = 0.f;
#pragma unroll
            for (int c = 0; c < 4; ++c)
#pragma unroll
                for (int r = 0; r < 16; ++r) { const float v = o[c][r] * inv - lam * xb[(c * 16 + r) * 64]; o[c][r] = v; ss += v * v; }
            ss += __shfl_xor(ss, 32);
            const float rstd = (1.f - LAMBDA_INIT) / sqrtf(ss * (1.f / 128.f) + NORM_EPS);
            bf16* orow = F.MIX + (size_t)(b * SEQ + q0w + r32e) * DM + h * 128 + 4 * hie;
#pragma unroll
            for (int c = 0; c < 4; ++c)
#pragma unroll
                for (int g = 0; g < 4; ++g) { const int dv = 32 * c + 8 * g + 4 * hie; const f32x4 gn = *(const f32x4*)(F.g_sub + dv);
                    v2u w; w.x = pk2(o[c][4 * g + 0] * rstd * gn[0], o[c][4 * g + 1] * rstd * gn[1]); w.y = pk2(o[c][4 * g + 2] * rstd * gn[2], o[c][4 * g + 3] * rstd * gn[3]);
                    *(GAS v2u*)(orow + 32 * c + 8 * g) = w; }
        }
        __syncthreads();
      }
    }
#pragma unroll 1
    while (cvp < cvend) { asm volatile("s_waitcnt vmcnt(0)" ::: "memory"); cv_finish(cvc, lane, cvscr); ++cvp; if (cvp < cvend) { cvc = cv_decode(F, cvp, wid); cv_issue(cvc, lane, cvscr); } }
}
#endif
__device__ __forceinline__ void p5_router(Frame& F) {
    const int lane = F.lane, tid = F.tid, fr = lane & 15, fq = lane >> 4;
    LAS float* LG = (LAS float*)(F.lds + RING_OFF);
    LAS float* SS = LG + 2 * 64 * 48;
    LAS int* cpart = (LAS int*)(SS + 128);
    LAS int* se = cpart + 64;
    const int tt = F.wave & 3, kh = F.wave >> 2;
    for (int c = F.vcu; c < NTOK / 64; c += F.G) {
        {
            const float* hrow = F.out + (size_t)(c * 64 + tt * 16 + fr) * DM + kh * 512 + fq * 8;
            const float* grow = F.g_ffn + kh * 512 + fq * 8; unsigned char* orow = (unsigned char*)F.HN2 + ((size_t)(c * 64 + tt * 16 + fr) * DM + kh * 512 + fq * 8) * MOE_ESZ;
            const bf16* wh = F.Wr_hi + (size_t)fr * DM + kh * 512 + fq * 8; const bf16* wl = F.Wr_lo + (size_t)fr * DM + kh * 512 + fq * 8;
            f32x4 acc[3]; acc[0] = acc[1] = acc[2] = (f32x4){0.f, 0.f, 0.f, 0.f};
            float ss = 0.f;
#pragma unroll 4
            for (int s = 0; s < 16; ++s) {
                const f32x4 a0 = *(const GAS f32x4*)(hrow + 32 * s), a1 = *(const GAS f32x4*)(hrow + 32 * s + 4);
                { const f32x4 g0 = *(const GAS f32x4*)(grow + 32 * s), g1 = *(const GAS f32x4*)(grow + 32 * s + 4);
#if MOE_FP8
                  v2u hv; hv.x = pk4_fp8(a0.x * g0.x * XSCALE, a0.y * g0.y * XSCALE, a0.z * g0.z * XSCALE, a0.w * g0.w * XSCALE); hv.y = pk4_fp8(a1.x * g1.x * XSCALE, a1.y * g1.y * XSCALE, a1.z * g1.z * XSCALE, a1.w * g1.w * XSCALE);
                  *(GAS v2u*)((unsigned char*)orow + 32 * s) = hv; }
#else
                  v4u hv; hv.x = pk2(a0.x * g0.x, a0.y * g0.y); hv.y = pk2(a0.z * g0.z, a0.w * g0.w); hv.z = pk2(a1.x * g1.x, a1.y * g1.y); hv.w = pk2(a1.z * g1.z, a1.w * g1.w);
                  *(GAS v4u*)((unsigned char*)orow + 64 * s) = hv; }
#endif
                ss += (a0.x * a0.x + a0.y * a0.y) + (a0.z * a0.z + a0.w * a0.w) + (a1.x * a1.x + a1.y * a1.y) + (a1.z * a1.z + a1.w * a1.w);
                v4u hi; hi.x = pk2(a0.x, a0.y); hi.y = pk2(a0.z, a0.w); hi.z = pk2(a1.x, a1.y); hi.w = pk2(a1.z, a1.w);
                v4u lo; lo.x = pk2(a0.x - bflo(hi.x), a0.y - bfhi(hi.x)); lo.y = pk2(a0.z - bflo(hi.y), a0.w - bfhi(hi.y)); lo.z = pk2(a1.x - bflo(hi.z), a1.y - bfhi(hi.z)); lo.w = pk2(a1.z - bflo(hi.w), a1.w - bfhi(hi.w));
                const bf16x8 ah = __builtin_bit_cast(bf16x8, hi), al = __builtin_bit_cast(bf16x8, lo);
#pragma unroll
                for (int ct = 0; ct < 3; ++ct) {
                    const bf16x8 bh = *(const GAS bf16x8*)(wh + (size_t)ct * 16 * DM + 32 * s), bl = *(const GAS bf16x8*)(wl + (size_t)ct * 16 * DM + 32 * s);
                    acc[ct] = __builtin_amdgcn_mfma_f32_16x16x32_bf16(ah, bh, acc[ct], 0, 0, 0);
                    acc[ct] = __builtin_amdgcn_mfma_f32_16x16x32_bf16(ah, bl, acc[ct], 0, 0, 0);
                    acc[ct] = __builtin_amdgcn_mfma_f32_16x16x32_bf16(al, bh, acc[ct], 0, 0, 0);
                }
            }
            ss += __shfl_xor(ss, 16); ss += __shfl_xor(ss, 32);
            if (fq == 0) SS[kh * 64 + tt * 16 + fr] = ss;
#pragma unroll
            for (int ct = 0; ct < 3; ++ct)
#pragma unroll
                for (int r = 0; r < 4; ++r) LG[(kh * 64 + tt * 16 + 4 * fq + r) * 48 + ct * 16 + fr] = acc[ct][r];
        }
        __syncthreads();
        if (tid < 64) {
            const int t = c * 64 + tid;
            const float rstd = 1.f / sqrtf((SS[tid] + SS[64 + tid]) * (1.f / DM) + NORM_EPS);
            const LAS float* l0 = LG + tid * 48; const LAS float* l1 = LG + (64 + tid) * 48;
            float g4[4];
#pragma unroll
            for (int a = 0; a < 4; ++a) g4[a] = (l0[a] + l1[a]) * rstd;
            int gs = 0; float gm = g4[0];
#pragma unroll
            for (int a = 1; a < 4; ++a) if (g4[a] > gm) { gm = g4[a]; gs = a; }
            float den = 0.f;
#pragma unroll
            for (int a = 0; a < 4; ++a) den += expf(g4[a] - gm);
            const float ggate = 1.f / den;
            float el[8];
#pragma unroll
            for (int a = 0; a < 8; ++a) el[a] = (l0[4 + gs * 8 + a] + l1[4 + gs * 8 + a]) * rstd;
            int i1 = 0; float v1 = el[0];
#pragma unroll
            for (int a = 1; a < 8; ++a) if (el[a] > v1) { v1 = el[a]; i1 = a; }
            int i2 = -1; float v2 = -INFINITY;
#pragma unroll
            for (int a = 0; a < 8; ++a) if (a != i1 && el[a] > v2) { v2 = el[a]; i2 = a; }
            const float d = expf(v2 - v1), w1 = ggate / (1.f + d), w2 = ggate * d / (1.f + d);
            F.tok_e[2 * t] = gs * 8 + i1; F.tok_e[2 * t + 1] = gs * 8 + i2; F.tok_w[2 * t] = w1; F.tok_w[2 * t + 1] = w2; se[2 * tid] = gs * 8 + i1; se[2 * tid + 1] = gs * 8 + i2;
            F.tok_rs[t] = rstd;
        }
        __syncthreads();
        if (tid < 128) { const int myE = se[tid]; int mycnt = 0;
#pragma unroll 4
            for (int e = 0; e < NE; ++e) { const unsigned long long mk = __ballot(myE == e); if (lane == e) mycnt = __popcll(mk); }
            if (lane < NE) cpart[F.wave * NE + lane] = mycnt; }
        __syncthreads();
        if (tid < NE) F.ccnt[c * NE + tid] = cpart[tid] + cpart[NE + tid];
        __syncthreads();
    }
}
__device__ __forceinline__ void p6_slots(Frame& F) {
    const int tid = F.tid, lane = F.lane;
    LAS int* part = (LAS int*)(F.lds + RING_OFF);
    LAS int* cnt = part + 512;
    LAS int* pstart = cnt + 32;
    LAS int* pref = pstart + 32;
    LAS int* se = pref + 32;
    LAS int* dst = se + 128;
    LAS int* w0cnt = dst + 128;
    LAS int* tab = (LAS int*)(F.lds + TAB_OFF);
    { const int e = tid & 31, p = tid >> 5; int s = 0; for (int c = p * 16; c < p * 16 + 16; ++c) s += F.ccnt[c * NE + e]; part[p * 32 + e] = s; }
    __syncthreads();
    if (tid < NE) { int s = 0; for (int p = 0; p < 16; ++p) s += part[p * 32 + tid]; cnt[tid] = s; }
    __syncthreads();
    if (tid == 0) { int acc = 0; for (int e = 0; e < NE; ++e) { pstart[e] = acc; const int nt = (cnt[e] + 255) >> 8; for (int i = 0; i < nt; ++i) tab[1 + (acc >> 8) + i] = e; acc += nt << 8; } tab[0] = acc >> 8; }
    __syncthreads();
    if (blockIdx.x == 0) { const int nT = tab[0]; for (int i = tid; i <= nT; i += NWAVES * 64) F.ttab[i] = tab[i]; }
    for (int c = F.vcu; c < NTOK / 64; c += F.G) {
        { const int e = tid & 31, p = tid >> 5; int s = 0; for (int cc = p * 16; cc < p * 16 + 16; ++cc) if (cc < c) s += F.ccnt[cc * NE + e]; part[p * 32 + e] = s; }
        if (tid < 128) se[tid] = F.tok_e[c * 128 + tid];
        __syncthreads();
        if (tid < NE) { int s = 0; for (int p = 0; p < 16; ++p) s += part[p * 32 + tid]; pref[tid] = s; }
        __syncthreads();
        int myrank = 0;
        if (tid < 128) { const int e = se[tid]; const unsigned long long below = (1ull << lane) - 1ull;
#pragma unroll 4
            for (int ee = 0; ee < NE; ++ee) { const unsigned long long mk = __ballot(e == ee); if (e == ee) myrank = __popcll(mk & below); if (F.wave == 0 && lane == ee) w0cnt[ee] = __popcll(mk); } }
        __syncthreads();
        if (tid < 128) { const int e = se[tid]; const int r = myrank + (F.wave == 1 ? w0cnt[e] : 0);
            const int d = pstart[e] + pref[e] + r; F.slot_tok[d] = c * 128 + tid; F.slot_w[d] = F.tok_w[c * 128 + tid]; F.slot_rs[d] = F.tok_rs[c * 64 + (tid >> 1)]; }
        __syncthreads();
    }
}
__device__ __forceinline__ int load_tile_table(Frame& F) {
    LAS int* tab = (LAS int*)(F.lds + TAB_OFF);
    int nT = F.ttab[0]; nT = nT < 0 ? 0 : (nT > MAXT ? MAXT : nT);
    for (int i = F.tid; i <= nT; i += NWAVES * 64) tab[i] = F.ttab[i];
    __syncthreads();
    return __builtin_amdgcn_readfirstlane(nT);
}
template <bool DUMMY> __device__ __forceinline__ void p9_combine(Frame& F) {
    const int gw = F.vcu * NWAVES + F.wave, NGW = F.G * NWAVES, lane = F.lane;
    for (int t = gw; t < NTOK; t += NGW) {
        GAS f32x4* orow = (GAS f32x4*)(F.out + (size_t)t * DM); GAS f32x4* wrow = DUMMY ? (GAS f32x4*)((float*)F.ACT + (size_t)(t & 8191) * DM) : orow;
        const GAS v4u* y0 = (const GAS v4u*)(F.Y2 + (size_t)(2 * t) * DM); const GAS v4u* y1 = (const GAS v4u*)(F.Y2 + (size_t)(2 * t + 1) * DM);
#pragma unroll
        for (int j = 0; j < 2; ++j) { const int ch = lane + 64 * j; const v4u a = y0[ch], b = y1[ch]; f32x4 h0 = orow[2 * ch], h1 = orow[2 * ch + 1];
            h0.x += bflo(a.x) + bflo(b.x); h0.y += bfhi(a.x) + bfhi(b.x); h0.z += bflo(a.y) + bflo(b.y); h0.w += bfhi(a.y) + bfhi(b.y);
            h1.x += bflo(a.z) + bflo(b.z); h1.y += bfhi(a.z) + bfhi(b.z); h1.z += bflo(a.w) + bflo(b.w); h1.w += bfhi(a.w) + bfhi(b.w);
            wrow[2 * ch] = h0; wrow[2 * ch + 1] = h1; }
    }
}
struct Args { const void* in[20]; float* out; unsigned char* ws; int ph_lo, ph_hi, li, pad; };
#if SIMPLE_GEMM
#define RUN_GEMM(EpiT, SchedT, ALIGN, g, S, E) pg8::simple_gemm_phase<EpiT, SchedT>(g, S, E)
#else
#define RUN_GEMM(EpiT, SchedT, ALIGN, g, S, E) pg8::gemm_phase<EpiT, SchedT, ALIGN, true>(F.lds + RING_OFF, g, S, E, F.wave)
#endif
#define RUN_GEMM_X(EpiT, SchedT, ALIGN, GATHER, G64, g, S, E) pg8::gemm_phase<EpiT, SchedT, ALIGN, true, GATHER, G64>(F.lds + RING_OFF, g, S, E, F.wave)
__device__ __forceinline__ int hw_lane_fresh() { int l; asm volatile("v_mbcnt_lo_u32_b32 %0, -1, 0\n\tv_mbcnt_hi_u32_b32 %0, -1, %0" : "=v"(l)); return l; }
__global__ void __launch_bounds__(NWAVES * 64, 2) fwd(Args args) {
    extern __shared__ __attribute__((aligned(16))) unsigned char lds[];
    Frame F;
    F.lds = (LAS unsigned char*)lds;
    F.MISC = (volatile LAS unsigned*)(F.lds + MISC_OFF);
    F.tid = threadIdx.x; F.lane = F.tid & 63; F.wave = __builtin_amdgcn_readfirstlane(F.tid >> 6);
    F.G = gridDim.x; { const int bx = blockIdx.x; F.vcu = (F.G % 8 == 0) ? (bx % 8) * (F.G / 8) + bx / 8 : bx; }
    unsigned char* ws = args.ws;
    F.ctl = (gu32*)(ws + WS_CTL);
    F.x = (const float*)args.in[0]; F.pos = (const int*)args.in[1]; F.g_attn = (const float*)args.in[2]; F.w_in = (const float*)args.in[3];
    F.g_q = (const float*)args.in[4]; F.g_k = (const float*)args.in[5]; F.lq1 = (const float*)args.in[6]; F.lk1 = (const float*)args.in[7];
    F.lq2 = (const float*)args.in[8]; F.lk2 = (const float*)args.in[9]; F.g_sub = (const float*)args.in[10]; F.conv_w = (const float*)args.in[11];
    F.g_conv = (const float*)args.in[12]; F.w_out = (const float*)args.in[13]; F.g_ffn = (const float*)args.in[14]; F.w_gr = (const float*)args.in[15];
    F.w_er = (const float*)args.in[16]; F.w_gate = (const float*)args.in[17]; F.w_up = (const float*)args.in[18]; F.w_down = (const float*)args.in[19];
    F.out = args.out;
    F.Wt_in = (bf16*)(ws + WS_WIN); F.Wt_out = (bf16*)(ws + WS_WOUT); F.Wt_gu = (bf16*)(ws + WS_WGU); F.Wt_d = (bf16*)(ws + WS_WD);
    F.HN = (bf16*)args.out;
    F.PROJ = (bf16*)(ws + WS_PROJ); F.MIX = (bf16*)(ws + WS_MIX); F.HN2 = (bf16*)(ws + WS_HN2); F.ACT = (bf16*)(ws + WS_ACT); F.Y2 = (bf16*)(ws + WS_Y2);
    F.tok_e = (int*)(ws + WS_SMALL + SM_TOKE); F.tok_w = (float*)(ws + WS_SMALL + SM_TOKW); F.slot_tok = (int*)(ws + WS_SMALL + SM_SLOTT); F.slot_w = (float*)(ws + WS_SMALL + SM_SLOTW);
    F.ccnt = (int*)(ws + WS_SMALL + SM_CCNT); F.ttab = (int*)(ws + WS_SMALL + SM_TTAB); F.Wr_hi = (bf16*)(ws + WS_SMALL + SM_WRH); F.Wr_lo = (bf16*)(ws + WS_SMALL + SM_WRL); F.tok_rs = (float*)(ws + WS_SMALL + SM_TOKRS); F.slot_rs = (float*)(ws + WS_SMALL + SM_SLOTRS); F.cs = (float*)(ws + WS_CS);
    for (int u = F.tid; u < (LDS_BYTES - LDSCTL_OFF) / 4; u += NWAVES * 64) ((LAS unsigned*)(F.lds + LDSCTL_OFF))[u] = 0u;
    __syncthreads();
    XcdBarrier bar; bar.bar = (unsigned*)(F.ctl + CW_BAR); bar.x = 0; bar.st = nullptr;
    if (N_LAUNCHES == 1) bar = xcd_barrier_post((unsigned*)(F.ctl + CW_BAR), F.MISC + 8);
#define HW_LANE() hw_lane_fresh()
#define GRID_BAR() do { if (N_LAUNCHES == 1) xcd_barrier(bar, F.wave == 0 && HW_LANE() == 0); } while (0)
    const int lo = args.ph_lo, hi = args.ph_hi;
#define IN(k) (lo <= (k) && (k) < hi)
#define BOTH(k) (IN(k) && IN((k) + 1))

#define PH0() do { p0_prologue(F); } while (0)
#define PH1() do { pg8::Gemm g{F.HN, F.Wt_in, NTOK, INC, DM}; pg8::StaticOrder S; S.init(NTOK, INC, F.G, (int)blockIdx.x); pg8::EpiProjQK E{F.PROJ, INC, F.g_q, F.g_k, F.cs, QSCALE, NORM_EPS}; \
        RUN_GEMM_X(pg8::EpiProjQK, pg8::StaticOrder, true, false, true, g, S, E); } while (0)
#define PH3() do { p2_conv(F); if (DUP(2)) p2_conv(F); p3_attention(F); } while (0)
#define PH4() do { pg8::Gemm g{F.MIX, F.Wt_out, NTOK, DM, DM}; pg8::StaticOrder S; S.init(NTOK, DM, F.G, (int)blockIdx.x); pg8::EpiResidual E{F.x, F.out, DM}; \
        RUN_GEMM(pg8::EpiResidual, pg8::StaticOrder, true, g, S, E); } while (0)
#define PH5() do { p5_router(F); } while (0)
#define PH6() do { p6_slots(F); } while (0)
#define PH7() do { const int nT = load_tile_table(F); pg8::MoeOrder S; S.init((const LAS int*)(F.lds + TAB_OFF) + 1, nT, F.G, (int)blockIdx.x); \
        LAS unsigned* lists = (LAS unsigned*)(F.lds + LIST_OFF); \
        { pg8::Unit u_; for (int i_ = 0; i_ < MAXLIST && S.next(i_, u_); ++i_) if (F.tid < 256) { const int tk_ = F.slot_tok[u_.pm * 256 + F.tid]; lists[i_ * 256 + F.tid] = tk_ >= 0 ? (unsigned)(tk_ >> 1) * (unsigned)(DM * MOE_ESZ) : 0u; } } \
        __syncthreads(); \
        pg8::Gemm g{F.HN2, F.Wt_gu, NTOK, NE * 1024, DM * MOE_ESZ / 2, lists}; pg8::EpiSwiglu<MOE_FP8_DOWN != 0> E{(void*)F.ACT, F.slot_rs, 1.0f / (XSCALE * WSCALE)}; \
        pg8::gemm_phase<pg8::EpiSwiglu<MOE_FP8_DOWN != 0>, pg8::MoeOrder, true, true, true, false, MOE_FP8 != 0>(F.lds + RING_OFF, g, S, E, F.wave); } while (0)
#define PH8() do { const int nT = load_tile_table(F); pg8::Gemm g{F.ACT, F.Wt_d, MAXSLOT, NE * 1024, DFF * DOWN_ESZ / 2}; pg8::MoeOrder S; S.init((const LAS int*)(F.lds + TAB_OFF) + 1, nT, F.G, (int)blockIdx.x); \
        pg8::EpiDown E{F.Y2, F.slot_tok, F.slot_w, 1.0f / WSCALE_D}; \
        pg8::gemm_phase<pg8::EpiDown, pg8::MoeOrder, true, true, false, false, MOE_FP8_DOWN != 0>(F.lds + RING_OFF, g, S, E, F.wave); } while (0)
#define PH9() do { if (DUP(9)) { p9_combine<true>(F); __syncthreads(); } p9_combine<false>(F); } while (0)
#define REFRESH() do { const int l_ = HW_LANE(); F.lane = l_; F.tid = F.wave * 64 + l_; } while (0)
#define PHASE(k, BODY) if (IN(k)) { REFRESH(); BODY(); if (DUP(k) && (k) != 3) { __syncthreads(); BODY(); } if (BOTH(k)) { GRID_BAR(); if ((k) == 4) for (int xb_ = 0; xb_ < PROBE_XBAR; ++xb_) GRID_BAR(); } }
    PHASE(0, PH0) PHASE(1, PH1) PHASE(3, PH3) PHASE(4, PH4) PHASE(5, PH5) PHASE(6, PH6) PHASE(7, PH7) PHASE(8, PH8)
    if (IN(9)) { REFRESH(); PH9(); }
#undef IN
#undef BOTH
}

extern "C" void kernel_launch(void* const* d_in, const int* in_sizes, int n_in, void* d_out, int out_size, void* d_ws, size_t ws_size, hipStream_t stream) {
    static int grid = 0;
    if (grid == 0) {
        if (n_in != 20 || in_sizes[0] != NTOK * DM || out_size != NTOK * DM || ws_size < WS_END) { fprintf(stderr, "kernel_launch: unexpected shapes (n_in %d, in0 %d, out %d, ws %zu); nothing launched\n", n_in, n_in > 0 ? in_sizes[0] : -1, out_size, ws_size); grid = -1; return; }
        int dev = 0, cus = 0, per_cu = 0;
        if (hipGetDevice(&dev) != hipSuccess || hipDeviceGetAttribute(&cus, hipDeviceAttributeMultiprocessorCount, dev) != hipSuccess) { grid = -1; return; }
        if (hipFuncSetAttribute((const void*)fwd, hipFuncAttributeMaxDynamicSharedMemorySize, LDS_BYTES) != hipSuccess) { fprintf(stderr, "kernel_launch: hipFuncSetAttribute failed\n"); grid = -1; return; }
        if (hipOccupancyMaxActiveBlocksPerMultiprocessor(&per_cu, (const void*)fwd, NWAVES * 64, LDS_BYTES) != hipSuccess || per_cu < 1) { fprintf(stderr, "kernel_launch: occupancy query reports %d workgroups per CU\n", per_cu); per_cu = 1; }
        (void)hipGetLastError();
        grid = cus;
    }
    if (grid < 0) return;
    if (hipMemsetAsync((char*)d_ws + WS_CTL, 0, CTL_ZERO_BYTES, stream) != hipSuccess) return;
    Args a{};
    for (int i = 0; i < 20; ++i) a.in[i] = d_in[i];
    a.out = (float*)d_out; a.ws = (unsigned char*)d_ws;
    if (N_LAUNCHES == 1) { a.ph_lo = 0; a.ph_hi = PER_PHASE; a.li = 0; hipLaunchKernelGGL(fwd, dim3(grid), dim3(NWAVES * 64), LDS_BYTES, stream, a); }
    else for (int li = 0; li < PER_PHASE; ++li) { a.ph_lo = li; a.ph_hi = li + 1; a.li = li; hipLaunchKernelGGL(fwd, dim3(grid), dim3(NWAVES * 64), LDS_BYTES, stream, a); }
}
```

```cpp
#include <hip/hip_runtime.h>
#include <cstdio>
#include <cstdint>
#ifndef MK_N_LAUNCHES
#define MK_N_LAUNCHES 1
#endif
#ifndef SIMPLE_GEMM
#define SIMPLE_GEMM 0
#endif
#ifndef NAIVE_ATTN
#define NAIVE_ATTN 0
#endif
#ifndef PROBE_DUP
#define PROBE_DUP 0
#endif
#define DUP(k) (((PROBE_DUP) >> (k)) & 1)
#ifndef PROBE_XBAR
#define PROBE_XBAR 0
#endif
#ifndef ATT_STAGGER
#define ATT_STAGGER 0
#endif
#ifndef MOE_FP8
#define MOE_FP8 1
#endif
#ifndef MOE_FP8_DOWN
#define MOE_FP8_DOWN 1
#endif
#ifndef P8_ALIGN
#define P8_ALIGN true
#endif
namespace pg8 {
#define PG8_LAS __attribute__((address_space(3)))
typedef unsigned short bf16_t;
typedef short bf16x8 __attribute__((ext_vector_type(8)));
typedef float f32x4 __attribute__((ext_vector_type(4)));
typedef unsigned u32x4 __attribute__((ext_vector_type(4)));
constexpr int BM = 256, BK = 64, HALF = 128, HTB = HALF * BK * 2  , STAGE_BYTES = 8 * HTB, NXCD = 8, WGM = 8;

__host__ __device__ __forceinline__ int lds_byte(int r, int c) { const int st = (r >> 4) * 2 + (c >> 5), rr = r & 15, cc = c & 31, ob = rr * 64 + cc * 2; return st * 1024 + (ob ^ (((ob >> 9) & 1) << 5)); }
__host__ __device__ __forceinline__ void stage_rc(int b, int& R, int& C) { const int st = b / 1024, sb = b % 1024, swz = sb ^ (((sb >> 9) & 1) << 5); R = (st >> 1) * 16 + swz / 64; C = (st & 1) * 32 + (swz % 64) / 2; }
__host__ __device__ __forceinline__ int perm32(int rho) { const int n = rho >> 4, i = rho & 15; return 8 * (i >> 2) + 4 * n + (i & 3); }

struct Unit { int pm, pn; };
struct Gemm { const bf16_t* A; const bf16_t* Bt; int M, N, K; const PG8_LAS unsigned* rowoff = nullptr; };

struct StaticOrder {
    int nM, nN, nwg, G, c;
    __host__ __device__ void init(int M, int N, int G_, int c_) { nM = M / BM; nN = N / BM; nwg = nM * nN; G = G_; c = c_; }
    __host__ __device__ bool next(int i, Unit& u) const {
        const long L = (long)i * G + c; if (L >= nwg) return false;
        int wgid = (int)L; { const int q = nwg / NXCD, r = nwg % NXCD, xcd = wgid % NXCD, off = wgid / NXCD; wgid = (xcd < r ? xcd * (q + 1) : r * (q + 1) + (xcd - r) * q) + off; }
        const int nig = WGM * nN, gid = wgid / nig, fm = gid * WGM, gsz = (nM - fm) < WGM ? (nM - fm) : WGM;
        u.pm = fm + ((wgid % nig) % gsz); u.pn = (wgid % nig) / gsz; return true;
    }
    __device__ __forceinline__ void a_ready(const Unit&) const {}
    __device__ __forceinline__ void done(const Unit&) const {}
};

__device__ __forceinline__ unsigned cvt_pk_bf16(float lo, float hi) { unsigned r; asm volatile("v_cvt_pk_bf16_f32 %0, %1, %2" : "=v"(r) : "v"(lo), "v"(hi)); return r; }
typedef unsigned u32x4e __attribute__((ext_vector_type(4)));
struct EpiStoreBf16 {
    static constexpr bool PERM = true, AFTER_DRAIN = false;
    bf16_t* O; int ldc;
    __device__ __forceinline__ void operator()(const f32x4 (&acc)[2][2][4][2], const Unit& u, int wr, int wc, int fr, int fq) const {
        const int row0 = u.pm * BM + wr * 64 + fr, col0 = u.pn * BM + wc * 32 + 8 * fq;
#pragma unroll
        for (int ai = 0; ai < 2; ++ai)
#pragma unroll
            for (int m = 0; m < 4; ++m) { bf16_t* rowp = O + (size_t)(row0 + ai * HALF + m * 16) * ldc + col0;
#pragma unroll
                for (int bj = 0; bj < 2; ++bj) { const f32x4 v0 = acc[ai][bj][m][0], v1 = acc[ai][bj][m][1];
                    u32x4 w; w.x = cvt_pk_bf16(v0[0], v0[1]); w.y = cvt_pk_bf16(v0[2], v0[3]); w.z = cvt_pk_bf16(v1[0], v1[1]); w.w = cvt_pk_bf16(v1[2], v1[3]);
                    *(u32x4*)(rowp + bj * HALF) = w; } }
    }
};
struct EpiProjQK {
    static constexpr bool PERM = true, AFTER_DRAIN = false;
    bf16_t* O; int ldc; const float* gq; const float* gk; const float* cs; float qscale, eps;
    __device__ __forceinline__ void operator()(const f32x4 (&acc)[2][2][4][2], const Unit& u, int wr, int wc, int fr, int fq) const {
        const int row0 = u.pm * BM + wr * 64 + fr, col0 = u.pn * BM + wc * 64 + 8 * fq;
        if (u.pn < 4) {
            const float* gsrc = u.pn < 2 ? gq : gk; const float gs = u.pn < 2 ? qscale : 1.0f;
            f32x4 gv[2][2];
#pragma unroll
            for (int bj = 0; bj < 2; ++bj)
#pragma unroll
                for (int n = 0; n < 2; ++n) gv[bj][n] = *(const f32x4*)(gsrc + 32 * bj + 8 * fq + 4 * n) * gs;
#pragma unroll
            for (int ai = 0; ai < 2; ++ai)
#pragma unroll
                for (int m = 0; m < 4; ++m) { const int row = row0 + ai * HALF + m * 16;
                    float ss = 0.f;
#pragma unroll
                    for (int bj = 0; bj < 2; ++bj)
#pragma unroll
                        for (int n = 0; n < 2; ++n) { const f32x4 v = acc[ai][bj][m][n]; ss += (v[0] * v[0] + v[1] * v[1]) + (v[2] * v[2] + v[3] * v[3]); }
                    ss += __shfl_xor(ss, 16); ss += __shfl_xor(ss, 32);
                    const float rstd = 1.0f / sqrtf(ss * (1.0f / 64.0f) + eps);
                    f32x4 v[2][2];
#pragma unroll
                    for (int bj = 0; bj < 2; ++bj)
#pragma unroll
                        for (int n = 0; n < 2; ++n) v[bj][n] = acc[ai][bj][m][n] * rstd * gv[bj][n];
                    const float* cr = cs + (size_t)row * 16;
#pragma unroll
                    for (int n = 0; n < 2; ++n) { const f32x4 c = *(const f32x4*)(cr + 4 * n), s = *(const f32x4*)(cr + 8 + 4 * n); f32x4 o;
#pragma unroll
                        for (int r = 0; r < 4; ++r) { const float mine = v[0][n][r], other = __shfl_xor(mine, 16); o[r] = fq == 0 ? (mine * c[r] - other * s[r]) : (fq == 1 ? (mine * c[r] + other * s[r]) : mine); }
                        v[0][n] = o; }
                    bf16_t* rowp = O + (size_t)row * ldc + col0;
#pragma unroll
                    for (int bj = 0; bj < 2; ++bj) { u32x4 w; w.x = cvt_pk_bf16(v[bj][0][0], v[bj][0][1]); w.y = cvt_pk_bf16(v[bj][0][2], v[bj][0][3]); w.z = cvt_pk_bf16(v[bj][1][0], v[bj][1][1]); w.w = cvt_pk_bf16(v[bj][1][2], v[bj][1][3]);
                        *(u32x4*)(rowp + bj * 32) = w; } }
        } else {
#pragma unroll
            for (int ai = 0; ai < 2; ++ai)
#pragma unroll
                for (int m = 0; m < 4; ++m) { bf16_t* rowp = O + (size_t)(row0 + ai * HALF + m * 16) * ldc + col0;
#pragma unroll
                    for (int bj = 0; bj < 2; ++bj) { const f32x4 v0 = acc[ai][bj][m][0], v1 = acc[ai][bj][m][1];
                        u32x4 w; w.x = cvt_pk_bf16(v0[0], v0[1]); w.y = cvt_pk_bf16(v0[2], v0[3]); w.z = cvt_pk_bf16(v1[0], v1[1]); w.w = cvt_pk_bf16(v1[2], v1[3]);
                        *(u32x4*)(rowp + bj * 32) = w; } }
        }
    }
};
struct EpiResidual {
    static constexpr bool PERM = false, AFTER_DRAIN = false;
    const float* X; float* O; int ldc;
    __device__ __forceinline__ void operator()(const f32x4 (&acc)[2][2][4][2], const Unit& u, int wr, int wc, int fr, int fq) const {
        const int row0 = u.pm * BM + wr * 64 + fr, col0 = u.pn * BM + wc * 32 + 4 * fq;
#pragma unroll
        for (int ai = 0; ai < 2; ++ai)
#pragma unroll
            for (int m = 0; m < 4; ++m) { const size_t off = (size_t)(row0 + ai * HALF + m * 16) * ldc + col0;
#pragma unroll
                for (int bj = 0; bj < 2; ++bj)
#pragma unroll
                    for (int n = 0; n < 2; ++n) { const size_t idx = off + bj * HALF + n * 16; *(f32x4*)(O + idx) = *(const f32x4*)(X + idx) + acc[ai][bj][m][n]; } }
    }
};
struct EpiResidualBf16 {
    static constexpr bool PERM = true, AFTER_DRAIN = false;
    const float* X; bf16_t* O; int ldc;
    __device__ __forceinline__ void operator()(const f32x4 (&acc)[2][2][4][2], const Unit& u, int wr, int wc, int fr, int fq) const {
        const int row0 = u.pm * BM + wr * 64 + fr, col0 = u.pn * BM + wc * 32 + 8 * fq;
#pragma unroll
        for (int ai = 0; ai < 2; ++ai)
#pragma unroll
            for (int m = 0; m < 4; ++m) { const size_t off = (size_t)(row0 + ai * HALF + m * 16) * ldc + col0;
#pragma unroll
                for (int bj = 0; bj < 2; ++bj) { const f32x4 v0 = *(const f32x4*)(X + off + bj * HALF) + acc[ai][bj][m][0], v1 = *(const f32x4*)(X + off + bj * HALF + 4) + acc[ai][bj][m][1];
                    u32x4 w; w.x = cvt_pk_bf16(v0[0], v0[1]); w.y = cvt_pk_bf16(v0[2], v0[3]); w.z = cvt_pk_bf16(v1[0], v1[1]); w.w = cvt_pk_bf16(v1[2], v1[3]);
                    *(u32x4*)(O + off + bj * HALF) = w; } }
    }
};
__device__ __forceinline__ float swiglu1(float g, float u) { return g * u * __builtin_amdgcn_rcpf(1.0f + __builtin_amdgcn_exp2f(g * -1.4426950408889634f)); }
__device__ __forceinline__ unsigned pk4_fp8(float a, float b, float c, float d) { int w = 0; w = __builtin_amdgcn_cvt_pk_fp8_f32(a, b, w, false); w = __builtin_amdgcn_cvt_pk_fp8_f32(c, d, w, true); return (unsigned)w; }
template <bool FP8OUT> struct EpiSwiglu {
    static constexpr bool PERM = true, AFTER_DRAIN = false;
    void* O; const float* slot_rs; float inscale;
    __device__ __forceinline__ void operator()(const f32x4 (&acc)[2][2][4][2], const Unit& u, int wr, int wc, int fr, int fq) const {
        const int row0 = u.pm * BM + wr * 64 + fr, col0 = (u.pn & 3) * HALF + wc * 32 + 8 * fq;
#pragma unroll
        for (int ai = 0; ai < 2; ++ai)
#pragma unroll
            for (int m = 0; m < 4; ++m) { const int row = row0 + ai * HALF + m * 16;
                const float rs = slot_rs[row] * inscale;
                const f32x4 g0 = acc[ai][0][m][0] * rs, g1 = acc[ai][0][m][1] * rs, u0 = acc[ai][1][m][0] * rs, u1 = acc[ai][1][m][1] * rs;
                if constexpr (FP8OUT) { typedef unsigned u32x2 __attribute__((ext_vector_type(2))); u32x2 w;
                    w.x = pk4_fp8(swiglu1(g0[0], u0[0]), swiglu1(g0[1], u0[1]), swiglu1(g0[2], u0[2]), swiglu1(g0[3], u0[3]));
                    w.y = pk4_fp8(swiglu1(g1[0], u1[0]), swiglu1(g1[1], u1[1]), swiglu1(g1[2], u1[2]), swiglu1(g1[3], u1[3]));
                    *(u32x2*)((unsigned char*)O + (size_t)row * 512 + col0) = w; }
                else { u32x4 w; w.x = cvt_pk_bf16(swiglu1(g0[0], u0[0]), swiglu1(g0[1], u0[1])); w.y = cvt_pk_bf16(swiglu1(g0[2], u0[2]), swiglu1(g0[3], u0[3]));
                    w.z = cvt_pk_bf16(swiglu1(g1[0], u1[0]), swiglu1(g1[1], u1[1])); w.w = cvt_pk_bf16(swiglu1(g1[2], u1[2]), swiglu1(g1[3], u1[3]));
                    *(u32x4*)((bf16_t*)O + (size_t)row * 512 + col0) = w; } }
    }
};
struct EpiDown {
    static constexpr bool PERM = true, AFTER_DRAIN = false;
    bf16_t* Y; const int* slot_tok; const float* slot_w; float outscale;
    __device__ __forceinline__ void operator()(const f32x4 (&acc)[2][2][4][2], const Unit& u, int wr, int wc, int fr, int fq) const {
        const int slot0 = u.pm * BM + wr * 64 + fr, col0 = (u.pn & 3) * BM + wc * 32 + 8 * fq;
#pragma unroll
        for (int ai = 0; ai < 2; ++ai)
#pragma unroll
            for (int m = 0; m < 4; ++m) { const int slot = slot0 + ai * HALF + m * 16; const int tok = slot_tok[slot];
                if (tok >= 0) { const float sw = slot_w[slot] * outscale; bf16_t* rowp = Y + (size_t)tok * 1024 + col0;
#pragma unroll
                    for (int bj = 0; bj < 2; ++bj) { const f32x4 v0 = acc[ai][bj][m][0] * sw, v1 = acc[ai][bj][m][1] * sw;
                        u32x4 w; w.x = cvt_pk_bf16(v0[0], v0[1]); w.y = cvt_pk_bf16(v0[2], v0[3]); w.z = cvt_pk_bf16(v1[0], v1[1]); w.w = cvt_pk_bf16(v1[2], v1[3]);
                        *(u32x4*)(rowp + bj * HALF) = w; } } }
    }
};
struct MoeOrder {
    const PG8_LAS int* tile_e; int nU, q, bpx, xcd, r;
    __device__ __forceinline__ void init(const PG8_LAS int* te, int nT, int G, int c) { tile_e = te; nU = 4 * nT; if (G % 8 == 0) { bpx = G / 8; xcd = c & 7; r = c >> 3; q = (nU + 7) / 8; } else { bpx = G; xcd = 0; r = c; q = nU; } }
    __device__ __forceinline__ bool next(int i, Unit& u) const {
        const int s = i * bpx + r; if (s >= q) return false;
        const int L = xcd * q + s; if (L >= nU) return false;
        const int pm = L >> 2; u.pm = pm; u.pn = __builtin_amdgcn_readfirstlane(tile_e[pm]) * 4 + (L & 3); return true;
    }
    __device__ __forceinline__ void a_ready(const Unit&) const {}
    __device__ __forceinline__ void done(const Unit&) const {}
};
template <class Epi, class Sched>
__device__ __forceinline__ void simple_gemm_phase(const Gemm g, const Sched& S, const Epi& E) {
    const int tid = threadIdx.x, wid = __builtin_amdgcn_readfirstlane(tid >> 6), lane = tid & 63, wr = wid >> 2, wc = wid & 3, fr = lane & 15, fq = lane >> 4;
    Unit u;
    for (int i = 0; S.next(i, u); ++i) {
        f32x4 acc[2][2][4][2];
#pragma unroll
        for (int a = 0; a < 2; ++a)
#pragma unroll
            for (int b = 0; b < 2; ++b)
#pragma unroll
                for (int m = 0; m < 4; ++m)
#pragma unroll
                    for (int n = 0; n < 2; ++n) acc[a][b][m][n] = (f32x4){0.f, 0.f, 0.f, 0.f};
        const bf16_t* Ab = g.A + (size_t)(u.pm * BM + wr * 64 + fr) * g.K + fq * 8;
        const int brow = Epi::PERM ? (wc * 32 + 8 * (fr >> 2) + (fr & 3)) : (wc * 32 + fr);
        const bf16_t* Bb = g.Bt + (size_t)(u.pn * BM + brow) * g.K + fq * 8;
        for (int k0 = 0; k0 < g.K; k0 += 32) {
            bf16x8 a[2][4], b[2][2];
#pragma unroll
            for (int ai = 0; ai < 2; ++ai)
#pragma unroll
                for (int m = 0; m < 4; ++m) a[ai][m] = *(const bf16x8*)(Ab + (size_t)(ai * HALF + m * 16) * g.K + k0);
#pragma unroll
            for (int bj = 0; bj < 2; ++bj)
#pragma unroll
                for (int n = 0; n < 2; ++n) b[bj][n] = *(const bf16x8*)(Bb + (size_t)(bj * HALF + (Epi::PERM ? 4 * n : 16 * n)) * g.K + k0);
#pragma unroll
            for (int ai = 0; ai < 2; ++ai)
#pragma unroll
                for (int bj = 0; bj < 2; ++bj)
#pragma unroll
                    for (int m = 0; m < 4; ++m)
#pragma unroll
                        for (int n = 0; n < 2; ++n) acc[ai][bj][m][n] = __builtin_amdgcn_mfma_f32_16x16x32_bf16(b[bj][n], a[ai][m], acc[ai][bj][m][n], 0, 0, 0);
        }
        E(acc, u, wr, wc, fr, fq);
    }
}
template <class Epi, class Sched, bool ALIGN_EPI = false, bool SP2 = false, bool GATHER = false, bool G64 = false, bool FP8 = false>
__device__ __forceinline__ void gemm_phase(PG8_LAS unsigned char* lds, const Gemm g, const Sched& S, const Epi& E, const int wave_  ) {
    int tid_ = wave_ * 64 + (int)__builtin_amdgcn_mbcnt_hi(~0u, __builtin_amdgcn_mbcnt_lo(~0u, 0u)); asm volatile("" : "+v"(tid_));
    const int tid = tid_, wid = __builtin_amdgcn_readfirstlane(tid >> 6), lane = tid & 63, wr = wid >> 2, wc = wid & 3, fr = lane & 15, fq = lane >> 4;
    const int K = g.K, nt = K / BK;
    static_assert(SP2 || (!GATHER && !G64), "GATHER / G64 are implemented on the SP2 loop only");
    unsigned voffA[2], voffB[2];
#pragma unroll
    for (int i = 0; i < 2; ++i) { int R, C; stage_rc(tid * 16 + i * 8192, R, C); const int Rb = Epi::PERM ? ((R & ~31) + perm32(R & 31)) : R;
        const int RbG = G64 ? ((Rb >> 5) * 64 + (Rb & 31)) : Rb;
        voffA[i] = (unsigned)(R * K + C) * 2u; voffB[i] = (unsigned)(RbG * K + C) * 2u; }
    const size_t kstep = (size_t)(BK * 2);
    const size_t hstep = (size_t)HALF * K * 2;
    const size_t tstep = 2 * hstep;
    const size_t hstepB = G64 ? (size_t)32 * K * 2 : hstep;
    const size_t tstepA = GATHER ? 0 : tstep;
    const unsigned ldsw = (unsigned)wid * 1024u;
    const int aoff = lds_byte(wr * 64 + fr, fq * 8), boff = lds_byte(wc * 32 + fr, fq * 8);
#define PG8_SA(b, h) (((b) * 2 + (h)) * HTB)
#define PG8_SB(b, h) ((4 + (b) * 2 + (h)) * HTB)
#define PG8_STAGE(bufoff, gbase, voff) do { _Pragma("unroll") for (int _i = 0; _i < 2; ++_i) \
        __builtin_amdgcn_global_load_lds((const unsigned*)((const char*)(gbase) + (voff)[_i]), (PG8_LAS unsigned*)(lds + (bufoff) + ldsw + _i * 8192), 16, 0, 0); } while (0)
#define PG8_LDA(dst, b, h) do { if constexpr (FP8) { _Pragma("unroll") for (int m = 0; m < 4; ++m) dst##8[m] = __builtin_shufflevector(*(const PG8_LAS v4i_*)(lds + PG8_SA(b, h) + aoff + m * 2048), *(const PG8_LAS v4i_*)(lds + PG8_SA(b, h) + aoff + m * 2048 + 1024), 0, 1, 2, 3, 4, 5, 6, 7); } \
        else { _Pragma("unroll") for (int m = 0; m < 4; ++m) _Pragma("unroll") for (int k = 0; k < 2; ++k) dst[m][k] = *(const PG8_LAS bf16x8*)(lds + PG8_SA(b, h) + aoff + m * 2048 + k * 1024); } } while (0)
#define PG8_LDB(dst, b, h) do { if constexpr (FP8) { _Pragma("unroll") for (int n = 0; n < 2; ++n) dst##8[n] = __builtin_shufflevector(*(const PG8_LAS v4i_*)(lds + PG8_SB(b, h) + boff + n * 2048), *(const PG8_LAS v4i_*)(lds + PG8_SB(b, h) + boff + n * 2048 + 1024), 0, 1, 2, 3, 4, 5, 6, 7); } \
        else { _Pragma("unroll") for (int n = 0; n < 2; ++n) _Pragma("unroll") for (int k = 0; k < 2; ++k) dst[n][k] = *(const PG8_LAS bf16x8*)(lds + PG8_SB(b, h) + boff + n * 2048 + k * 1024); } } while (0)
#define PG8_MMA(ai, bj, At, Bt) do { __builtin_amdgcn_s_setprio(1); _Pragma("unroll") for (int m = 0; m < 4; ++m) _Pragma("unroll") for (int n = 0; n < 2; ++n) { \
        if constexpr (FP8) { acc[ai][bj][m][n] = __builtin_amdgcn_mfma_scale_f32_16x16x128_f8f6f4(Bt##8[n], At##8[m], acc[ai][bj][m][n], 0, 0, 0, 127, 0, 127); } \
        else { _Pragma("unroll") for (int k = 0; k < 2; ++k) acc[ai][bj][m][n] = __builtin_amdgcn_mfma_f32_16x16x32_bf16(Bt[n][k], At[m][k], acc[ai][bj][m][n], 0, 0, 0); } } \
        __builtin_amdgcn_s_setprio(0); } while (0)
#define PG8_STAGE_A(bufoff, gbase, h, nx) do { if constexpr (GATHER) { PG8_STAGE(bufoff, gbase, vC[h]); }   \
        else { PG8_STAGE(bufoff, (gbase) + (h) * hstep, voffA); } } while (0)
#define PG8_GLIST(dst, u_) do { _Pragma("unroll") for (int i_ = 0; i_ < 2; ++i_) { int R_, C_; stage_rc(tid * 16 + i_ * 8192, R_, C_);   \
        _Pragma("unroll") for (int h_ = 0; h_ < 2; ++h_) dst[h_][i_] = g.rowoff[(u_) * 256 + h_ * 128 + R_] + (unsigned)C_ * 2u; } } while (0)
#define PG8_WAIT_V(n) asm volatile("s_waitcnt vmcnt(" #n ")" ::: "memory")
#define PG8_WAIT_L(n) asm volatile("s_waitcnt lgkmcnt(" #n ")" ::: "memory")
#define PG8_BAR __builtin_amdgcn_s_barrier()
#define PG8_SCHED __builtin_amdgcn_sched_barrier(0)
    Unit cur, nxt; int ui = 0;
    if (!S.next(0, cur)) return;
    f32x4 acc[2][2][4][2];
#pragma unroll
    for (int a = 0; a < 2; ++a)
#pragma unroll
        for (int b = 0; b < 2; ++b)
#pragma unroll
            for (int m = 0; m < 4; ++m)
#pragma unroll
                for (int n = 0; n < 2; ++n) acc[a][b][m][n] = (f32x4){0.f, 0.f, 0.f, 0.f};
    bf16x8 At[4][2], B0[2][2], B1[2][2];
    typedef int v4i_ __attribute__((ext_vector_type(4))); typedef int v8i_ __attribute__((ext_vector_type(8)));
    v8i_ At8[4], B08[2], B18[2];
    const char* cA = (const char*)g.A + (size_t)cur.pm * tstepA; const char* cB = (const char*)g.Bt + (size_t)cur.pn * tstep;
    unsigned vC[2][2];
    if constexpr (GATHER) { PG8_GLIST(vC, 0); }
    S.a_ready(cur);
    if constexpr (SP2) {
        PG8_STAGE(PG8_SB(0, 0), cB, voffB); PG8_STAGE(PG8_SB(0, 1), cB + hstepB, voffB); PG8_STAGE_A(PG8_SA(0, 0), cA, 0, false); PG8_STAGE_A(PG8_SA(0, 1), cA, 1, false);
        if (wr == 1) PG8_BAR;
        PG8_WAIT_V(2); PG8_BAR;
        PG8_STAGE(PG8_SB(1, 0), cB + kstep, voffB); PG8_STAGE_A(PG8_SA(1, 0), cA + kstep, 0, false); PG8_STAGE(PG8_SB(1, 1), cB + hstepB + kstep, voffB);
        PG8_WAIT_V(6); PG8_BAR;
    } else {
        PG8_STAGE(PG8_SB(0, 0), cB, voffB); PG8_STAGE(PG8_SA(0, 0), cA, voffA); PG8_STAGE(PG8_SB(0, 1), cB + hstep, voffB); PG8_STAGE(PG8_SA(0, 1), cA + hstep, voffA);
        if (wr == 1) PG8_BAR;
        PG8_WAIT_V(4); PG8_BAR;
        PG8_STAGE(PG8_SB(1, 0), cB + kstep, voffB); PG8_STAGE(PG8_SA(1, 0), cA + kstep, voffA); PG8_STAGE(PG8_SB(1, 1), cB + hstep + kstep, voffB);
        PG8_WAIT_V(6); PG8_BAR;
    }
    for (;;) {
        const bool has_next = S.next(ui + 1, nxt);
        const char* nA = has_next ? (const char*)g.A + (size_t)nxt.pm * tstepA : cA; const char* nB = has_next ? (const char*)g.Bt + (size_t)nxt.pn * tstep : cB;
#pragma clang loop unroll(disable)
        for (int t = 0; t < nt; t += 2) {
            const bool last = (t == nt - 2);
            const char* a1 = cA + (size_t)(t + 1) * kstep;
            const char* a2 = last ? nA : cA + (size_t)(t + 2) * kstep; const char* b2 = last ? nB : cB + (size_t)(t + 2) * kstep;
            const char* a3 = a2 + kstep; const char* b3 = b2 + kstep;
            if (last && has_next) S.a_ready(nxt);
            if constexpr (SP2) {
            PG8_LDB(B0, 0, 0); PG8_LDB(B1, 0, 1); PG8_SCHED; PG8_LDA(At, 0, 0); PG8_STAGE_A(PG8_SA(1, 1), a1, 1, false);
            if constexpr (GATHER) { if (last && has_next) { PG8_GLIST(vC, ui + 1); } }
            PG8_WAIT_V(8); PG8_WAIT_L(0); PG8_BAR; PG8_MMA(0, 0, At, B0); PG8_MMA(0, 1, At, B1); PG8_BAR; PG8_SCHED;
            PG8_LDA(At, 0, 1); PG8_STAGE(PG8_SB(0, 0), b2, voffB); PG8_STAGE(PG8_SB(0, 1), b2 + hstepB, voffB); PG8_STAGE_A(PG8_SA(0, 0), a2, 0, last);
            PG8_WAIT_V(8); PG8_WAIT_L(0); PG8_BAR; PG8_MMA(1, 0, At, B0); PG8_MMA(1, 1, At, B1); PG8_BAR; PG8_SCHED;
            PG8_LDB(B0, 1, 0); PG8_LDB(B1, 1, 1); PG8_SCHED; PG8_LDA(At, 1, 0); PG8_STAGE_A(PG8_SA(0, 1), a2, 1, last);
            PG8_WAIT_V(8); PG8_WAIT_L(0); PG8_BAR; PG8_MMA(0, 0, At, B0); PG8_MMA(0, 1, At, B1); PG8_BAR; PG8_SCHED;
            PG8_LDA(At, 1, 1); PG8_STAGE(PG8_SB(1, 0), b3, voffB); PG8_STAGE(PG8_SB(1, 1), b3 + hstepB, voffB); PG8_STAGE_A(PG8_SA(1, 0), a3, 0, last);
            PG8_WAIT_V(8); PG8_WAIT_L(0); PG8_BAR; PG8_MMA(1, 0, At, B0); PG8_MMA(1, 1, At, B1); PG8_BAR; PG8_SCHED;
            } else {
            PG8_LDB(B0, 0, 0); PG8_SCHED; PG8_LDA(At, 0, 0); PG8_STAGE(PG8_SA(1, 1), a1 + hstep, voffA);
            PG8_WAIT_L(8); PG8_BAR; PG8_WAIT_L(0); PG8_MMA(0, 0, At, B0); PG8_BAR; PG8_SCHED;
            PG8_LDB(B1, 0, 1); PG8_STAGE(PG8_SB(0, 0), b2, voffB);
            PG8_BAR; PG8_WAIT_L(0); PG8_MMA(0, 1, At, B1); PG8_BAR;
            PG8_LDA(At, 0, 1); PG8_STAGE(PG8_SA(0, 0), a2, voffA);
            PG8_BAR; PG8_WAIT_L(0); PG8_MMA(1, 0, At, B0); PG8_BAR; PG8_SCHED;
            PG8_STAGE(PG8_SB(0, 1), b2 + hstep, voffB);
            PG8_WAIT_V(6); PG8_BAR; PG8_MMA(1, 1, At, B1); PG8_BAR;
            PG8_LDB(B0, 1, 0); PG8_SCHED; PG8_LDA(At, 1, 0); PG8_STAGE(PG8_SA(0, 1), a2 + hstep, voffA);
            PG8_WAIT_L(8); PG8_BAR; PG8_WAIT_L(0); PG8_MMA(0, 0, At, B0); PG8_BAR; PG8_SCHED;
            PG8_LDB(B1, 1, 1); PG8_STAGE(PG8_SB(1, 0), b3, voffB);
            PG8_BAR; PG8_WAIT_L(0); PG8_MMA(0, 1, At, B1); PG8_BAR;
            PG8_LDA(At, 1, 1); PG8_STAGE(PG8_SA(1, 0), a3, voffA);
            PG8_BAR; PG8_WAIT_L(0); PG8_MMA(1, 0, At, B0); PG8_BAR; PG8_SCHED;
            PG8_STAGE(PG8_SB(1, 1), b3 + hstep, voffB);
            PG8_WAIT_V(6); PG8_BAR; PG8_MMA(1, 1, At, B1); PG8_BAR;
            }
        }
        if constexpr (ALIGN_EPI) { if (wr == 0) PG8_BAR; }
        if constexpr (!Epi::AFTER_DRAIN) { E(acc, cur, wr, wc, fr, fq); S.done(cur); }
        if (!has_next) break;
#pragma unroll
        for (int a = 0; a < 2; ++a)
#pragma unroll
            for (int b = 0; b < 2; ++b)
#pragma unroll
                for (int m = 0; m < 4; ++m)
#pragma unroll
                    for (int n = 0; n < 2; ++n) acc[a][b][m][n] = (f32x4){0.f, 0.f, 0.f, 0.f};
        cur = nxt; cA = nA; cB = nB; ++ui;
        if constexpr (ALIGN_EPI) { if (wr == 1) PG8_BAR; }
    }
    PG8_WAIT_V(0);
    if constexpr (!ALIGN_EPI) { if (wr == 0) PG8_BAR; }
    PG8_BAR;
    if constexpr (Epi::AFTER_DRAIN) { E.fused(acc, cur, wr, wc, fr, fq, lds, wid, lane); S.done(cur); }
#undef PG8_SA
#undef PG8_SB
#undef PG8_STAGE
#undef PG8_STAGE_A
#undef PG8_GLIST
#undef PG8_LDA
#undef PG8_LDB
#undef PG8_MMA
#undef PG8_WAIT_V
#undef PG8_WAIT_L
#undef PG8_BAR
#undef PG8_SCHED
}
}
constexpr int NWAVES = 8;
constexpr int N_LAUNCHES = MK_N_LAUNCHES;
constexpr int PER_PHASE = 10;
constexpr int NTOK = 16384, DM = 1024, SEQ = 2048, NBATCH = 8, NHEAD = 4;
constexpr int INC = 3072;
constexpr int KOFF = 512, VOFF = 1024, CBOFF = 1536, CCOFF = 2048, CUOFF = 2560;
constexpr int NE = 32, DFF = 512, MAXT = 160, MAXSLOT = MAXT * 256;
constexpr float NORM_EPS = 1e-6f;
constexpr float QSCALE = 0.125f * 1.4426950408889634f;
constexpr float LAMBDA_INIT = 0.2f;
constexpr float WSCALE = MOE_FP8 ? 64.0f : 1.0f, XSCALE = MOE_FP8 ? 4.0f : 1.0f;
constexpr int MOE_ESZ = MOE_FP8 ? 1 : 2, DOWN_ESZ = MOE_FP8_DOWN ? 1 : 2;
constexpr float WSCALE_D = MOE_FP8_DOWN ? 64.0f : 1.0f;
constexpr size_t MiB = 1u << 20;
constexpr size_t WS_CTL = 0, CTL_ZERO_BYTES = 65536;
constexpr size_t WS_WIN = 1 * MiB, WS_WOUT = 7 * MiB, WS_WGU = 9 * MiB, WS_WD = 73 * MiB;
constexpr size_t WS_PROJ = 105 * MiB;
constexpr size_t WS_ACT = 105 * MiB;
constexpr size_t WS_H = 145 * MiB;
constexpr size_t WS_HN2 = 177 * MiB;
constexpr size_t WS_MIX = 201 * MiB;
constexpr size_t WS_SMALL = 233 * MiB;
constexpr size_t SM_TOKE = 0, SM_TOKW = 131072, SM_SLOTT = 262144, SM_SLOTW = 262144 + 163840, SM_CCNT = 262144 + 2 * 163840, SM_TTAB = SM_CCNT + 32768, SM_WRH = SM_TTAB + 1024, SM_WRL = SM_WRH + 98304, SM_TOKRS = SM_WRL + 98304, SM_SLOTRS = SM_TOKRS + 65536;
constexpr size_t WS_CS = 235 * MiB;
constexpr size_t WS_END = 236 * MiB;
static_assert(WS_ACT + (size_t)MAXSLOT * 512 * 2 <= WS_H && WS_H + (size_t)NTOK * DM * 2 <= WS_HN2 && WS_HN2 + (size_t)NTOK * DM * 2 <= WS_SMALL && WS_PROJ + (size_t)NTOK * INC * 2 <= WS_MIX && WS_MIX + (size_t)NTOK * DM * 2 <= WS_SMALL && SM_SLOTRS + 163840 <= 2 * MiB, "d_ws map");
constexpr int CW_TMO = 0, CW_BAR = 4096;
constexpr int RING_OFF = 0, RING_BYTES = 131072;
constexpr int TAB_OFF = RING_BYTES;
constexpr int LIST_OFF = TAB_OFF + 1024, MAXLIST = 8;
constexpr int LDSCTL_OFF = LIST_OFF + MAXLIST * 1024, MISC_OFF = LDSCTL_OFF + 320;
constexpr int LDS_BYTES = 147456;
static_assert(MISC_OFF + 128 <= LDS_BYTES, "LDS map");
#define GAS __attribute__((address_space(1)))
#define LAS __attribute__((address_space(3)))
typedef unsigned short bf16;
typedef unsigned v4u __attribute__((ext_vector_type(4)));
typedef float f32x4 __attribute__((ext_vector_type(4)));
typedef short bf16x8 __attribute__((ext_vector_type(8)));
typedef GAS unsigned gu32;
typedef GAS unsigned long long gu64;
#define RLX_AGENT __ATOMIC_RELAXED, __HIP_MEMORY_SCOPE_AGENT
#define LDS_WAIT() asm volatile("s_waitcnt lgkmcnt(0)" ::: "memory")
#define VM_WAIT() asm volatile("s_waitcnt vmcnt(0)" ::: "memory")
__device__ __forceinline__ unsigned long long rt() { return __builtin_amdgcn_s_memrealtime(); }
__device__ __forceinline__ unsigned f2bf(float f) { unsigned u = __builtin_bit_cast(unsigned, f); return (u + 0x7fffu + ((u >> 16) & 1u)) >> 16; }
__device__ __forceinline__ unsigned pk4_fp8(float a, float b, float c, float d) { int w = 0; w = __builtin_amdgcn_cvt_pk_fp8_f32(a, b, w, false); w = __builtin_amdgcn_cvt_pk_fp8_f32(c, d, w, true); return (unsigned)w; }
typedef float f32x2_t __attribute__((ext_vector_type(2))); typedef __bf16 bf16x2_t __attribute__((ext_vector_type(2)));
__device__ __forceinline__ unsigned pk2(float lo, float hi) { const f32x2_t v = {lo, hi}; const bf16x2_t b = __builtin_convertvector(v, bf16x2_t); return __builtin_bit_cast(unsigned, b); }

#define XB_TMO      128
#define XB_XCNT(j)  (256  + 64 * (j))
#define XB_XSUB(j)  (1280 + 64 * (j))
#define XB_XGEN(j)  (2304 + 64 * (j))
#define XB_TOP      3328
#define XB_TOPGEN   3392
#define XCD_BAR_WORDS 3456
#define XB_SPIN_CAP (1u << 18)

__device__ __forceinline__ unsigned xb_ld(unsigned* p)              { return __hip_atomic_load(p, __ATOMIC_RELAXED, __HIP_MEMORY_SCOPE_AGENT); }
__device__ __forceinline__ unsigned xb_add(unsigned* p, unsigned v) { return __hip_atomic_fetch_add(p, v, __ATOMIC_RELAXED, __HIP_MEMORY_SCOPE_AGENT); }
__device__ __forceinline__ unsigned xb_xcc_id() { return (unsigned)__builtin_amdgcn_s_getreg((3 << 11) | 20) & 0xFu; }
#define XB_SPIN(cond, bar) do { unsigned _sp = 0; while (cond) { __builtin_amdgcn_s_sleep(1); \
    if ((++_sp & 255u) == 0u) { if (xb_ld(&(bar)[XB_TMO])) break; if (_sp > XB_SPIN_CAP) { atomicAdd(&(bar)[XB_TMO], 1u); break; } } } } while (0)

struct XcdBarrier {
    unsigned* bar; unsigned x;
    volatile LAS unsigned* st;
};

__device__ __forceinline__ XcdBarrier xcd_barrier_post(unsigned* bar, volatile LAS unsigned* st) {
    XcdBarrier b; b.bar = bar; b.x = xb_xcc_id(); b.st = st;
    if (threadIdx.x == 0) (void)xb_add(&bar[XB_XCNT(b.x)], 1u);
    return b;
}
__device__ __forceinline__ void xcd_barrier_complete(unsigned* bar, unsigned x, unsigned& nloc, unsigned& nx) {
    const unsigned G = gridDim.x * gridDim.y * gridDim.z;
    unsigned sum, cnt, mine, sp = 0u;
    for (;;) {
        sum = 0u; cnt = 0u; mine = 0u;
#pragma unroll
        for (unsigned j = 0; j < 16; ++j) { const unsigned c = xb_ld(&bar[XB_XCNT(j)]); sum += c; cnt += (c > 0u) ? 1u : 0u; mine = (j == x) ? c : mine; }
        if (sum == G) break;
        __builtin_amdgcn_s_sleep(1);
        if ((++sp & 255u) == 0u) { if (xb_ld(&bar[XB_TMO])) break; if (sp > XB_SPIN_CAP) { atomicAdd(&bar[XB_TMO], 1u); break; } }
    }
    nloc = mine > 0u ? mine : 1u; nx = cnt > 0u ? cnt : 1u;
}

__device__ __forceinline__ void xcd_barrier(const XcdBarrier& b, const bool t0  ) {
    asm volatile("s_waitcnt vmcnt(0)" ::: "memory");
    __syncthreads();
    if (t0) {
        unsigned* bar = b.bar;
        __builtin_amdgcn_s_waitcnt(0);
        unsigned nloc = b.st[0], nx = b.st[1];
        if (nloc == 0u) { xcd_barrier_complete(bar, b.x, nloc, nx); b.st[0] = nloc; b.st[1] = nx; }
        const unsigned old = xb_add(&bar[XB_XSUB(b.x)], 1u);
        const unsigned gen = old / nloc;
        if (old + 1u == (gen + 1u) * nloc) {
            __builtin_amdgcn_fence(__ATOMIC_RELEASE, "agent");
            asm volatile("s_waitcnt vmcnt(0)" ::: "memory");
            const unsigned og = xb_add(&bar[XB_TOP], 1u);
            const unsigned tg = og / nx;
            if (og + 1u == (tg + 1u) * nx) xb_add(&bar[XB_TOPGEN], 1u);
            else XB_SPIN(xb_ld(&bar[XB_TOPGEN]) == tg, bar);
            __builtin_amdgcn_fence(__ATOMIC_ACQUIRE, "agent");
            xb_add(&bar[XB_XGEN(b.x)], 1u);
            asm volatile("s_waitcnt vmcnt(0)" ::: "memory");
        } else {
            XB_SPIN(xb_ld(&bar[XB_XGEN(b.x)]) == gen, bar);
            __builtin_amdgcn_fence(__ATOMIC_ACQUIRE, "agent");
            asm volatile("s_waitcnt vmcnt(0)" ::: "memory");
        }
    }
    __syncthreads();
}
typedef short s16x4 __attribute__((ext_vector_type(4)));
typedef float f32x16 __attribute__((ext_vector_type(16)));
typedef unsigned v2u __attribute__((ext_vector_type(2)));
struct Frame {
    LAS unsigned char* lds;
    volatile LAS unsigned* MISC;
    gu32* ctl;
    int tid, lane, wave;
    int vcu, G;
    const float* x; const int* pos; const float *g_attn, *w_in, *g_q, *g_k, *lq1, *lk1, *lq2, *lk2, *g_sub, *conv_w, *g_conv, *w_out, *g_ffn, *w_gr, *w_er, *w_gate, *w_up, *w_down;
    float* out;
    bf16 *Wt_in, *Wt_out, *Wt_gu, *Wt_d, *Wr_hi, *Wr_lo;
    bf16 *HN, *PROJ, *MIX, *H, *HN2, *ACT, *Y2;
    float* cs;
    int* tok_e; float* tok_w; float* tok_rs; int* slot_tok; float* slot_w; float* slot_rs; int* ccnt; int* ttab;
};
__device__ __forceinline__ float wave_sum(float v) {
#pragma unroll
    for (int o = 1; o < 64; o <<= 1) v += __shfl_xor(v, o);
    return v;
}
__device__ __forceinline__ float wave_max(float v) {
#pragma unroll
    for (int o = 1; o < 64; o <<= 1) v = fmaxf(v, __shfl_xor(v, o));
    return v;
}
__device__ __forceinline__ float bf2f(unsigned short b) { return __builtin_bit_cast(float, (unsigned)b << 16); }
__device__ __forceinline__ float bflo(unsigned w) { return __builtin_bit_cast(float, w << 16); }
__device__ __forceinline__ float bfhi(unsigned w) { return __builtin_bit_cast(float, w & 0xffff0000u); }

__device__ __forceinline__ void p0_transpose_item(const float* W, int K, int N, bf16* WT, int k0, int n0, int dst_row0, LAS float* scr, int lane) {
#pragma unroll 8
    for (int i = 0; i < 32; ++i) { const int kk = 2 * i + (lane >> 5); scr[kk * 33 + (lane & 31)] = W[(size_t)(k0 + kk) * N + n0 + (lane & 31)]; }
    LDS_WAIT(); asm volatile("" ::: "memory");
    const int c = lane & 7;
#pragma unroll
    for (int j = 0; j < 4; ++j) { const int n = (lane >> 3) + 8 * j; const LAS float* s = scr + (8 * c) * 33 + n;
        v4u o; o.x = pk2(s[0 * 33], s[1 * 33]); o.y = pk2(s[2 * 33], s[3 * 33]); o.z = pk2(s[4 * 33], s[5 * 33]); o.w = pk2(s[6 * 33], s[7 * 33]);
        *(GAS v4u*)(WT + (size_t)(dst_row0 + n) * K + k0 + 8 * c) = o; }
    LDS_WAIT(); asm volatile("" ::: "memory");
}
__device__ __forceinline__ void rms_row_to_bf16(const float* xrow, const float* gain, bf16* orow, int lane) {
    const GAS f32x4* xr = (const GAS f32x4*)xrow + lane; const GAS f32x4* gr = (const GAS f32x4*)gain + lane;
    f32x4 v[4]; float s = 0.f;
#pragma unroll
    for (int j = 0; j < 4; ++j) { v[j] = xr[64 * j]; s += (v[j].x * v[j].x + v[j].y * v[j].y) + (v[j].z * v[j].z + v[j].w * v[j].w); }
    const float rstd = 1.f / sqrtf(wave_sum(s) * (1.f / DM) + NORM_EPS);
    GAS unsigned long long* o8 = (GAS unsigned long long*)orow + lane;
#pragma unroll
    for (int j = 0; j < 4; ++j) { const f32x4 g = gr[64 * j]; o8[64 * j] = (unsigned long long)pk2(v[j].x * rstd * g.x, v[j].y * rstd * g.y) | ((unsigned long long)pk2(v[j].z * rstd * g.z, v[j].w * rstd * g.w) << 32); }
}
__device__ __forceinline__ void p0_prologue(Frame& F) {
    LAS float* scr = (LAS float*)(F.lds + RING_OFF + F.wave * 16384);
    const int gw = F.vcu * NWAVES + F.wave, NGW = F.G * NWAVES;
    constexpr int I_IN = (DM / 64) * (INC / 32), I_OUT = (DM / 64) * (DM / 32);
    constexpr int NITEMS = I_IN + I_OUT;
    for (int it = gw; it < NITEMS; it += NGW) {
        int r = it;
        if (r < I_IN) { const int kb = r / (INC / 32), nb = r % (INC / 32); p0_transpose_item(F.w_in, DM, INC, F.Wt_in, 64 * kb, 32 * nb, 32 * nb, scr, F.lane); continue; } r -= I_IN;
        { const int kb = r / (DM / 32), nb = r % (DM / 32); p0_transpose_item(F.w_out, DM, DM, F.Wt_out, 64 * kb, 32 * nb, 32 * nb, scr, F.lane); }
    }
    for (int m = gw; m < NTOK; m += NGW) rms_row_to_bf16(F.x + (size_t)m * DM, F.g_attn, F.HN + (size_t)m * DM, F.lane);
    for (int i = gw * 64 + F.lane; i < MAXSLOT; i += NGW * 64) F.slot_tok[i] = -1;
    for (int i = gw * 64 + F.lane; i < NTOK * 8; i += NGW * 64) { const int t = i >> 3, j = i & 7;
        const float fr = exp2f(-(float)j * (18.931568569324174f / 8.0f)); const float ang = (float)F.pos[t] * fr;
        const float rev = __builtin_amdgcn_fractf(ang * 0.15915494309189535f); F.cs[t * 16 + j] = __builtin_amdgcn_cosf(rev); F.cs[t * 16 + 8 + j] = __builtin_amdgcn_sinf(rev); }
    for (int i = gw * 64 + F.lane; i < 48 * DM; i += NGW * 64) { const int cidx = i >> 10, k = i & (DM - 1); float w = 0.f;
        if (cidx < 4) w = F.w_gr[k * 4 + cidx] * F.g_ffn[k]; else if (cidx < 36) { const int e = cidx - 4; w = F.w_er[((size_t)(e >> 3) * DM + k) * 8 + (e & 7)] * F.g_ffn[k]; }
        const unsigned hb = f2bf(w); const float hf = __builtin_bit_cast(float, hb << 16); F.Wr_hi[i] = (bf16)hb; F.Wr_lo[i] = (bf16)f2bf(w - hf); }
}

__device__ __forceinline__ void p2_conv(Frame& F) {
    const int gw = F.vcu * NWAVES + F.wave, NGW = F.G * NWAVES, lane = F.lane;
    float cw0[8], cw1[8], cw2[8], gc[8];
#pragma unroll
    for (int j = 0; j < 8; ++j) { cw0[j] = F.conv_w[lane * 8 + j]; cw1[j] = F.conv_w[512 + lane * 8 + j]; cw2[j] = F.conv_w[1024 + lane * 8 + j]; gc[j] = F.g_conv[lane * 8 + j]; }
    for (int t = gw; t < NTOK; t += NGW) {
        bf16* row = F.PROJ + (size_t)t * INC;
        {
            const int ts = t & (SEQ - 1);
            float z[8];
#pragma unroll
            for (int j = 0; j < 8; ++j) z[j] = 0.f;
#pragma unroll
            for (int d = 0; d < 3; ++d) {
                if (ts - d >= 0) {
                    const bf16* rr = row - (size_t)d * INC;
                    const v4u c = *((const GAS v4u*)(rr + CCOFF) + lane), u = *((const GAS v4u*)(rr + CUOFF) + lane);
                    float y[8];
                    y[0] = bflo(c.x) * bflo(u.x); y[1] = bfhi(c.x) * bfhi(u.x); y[2] = bflo(c.y) * bflo(u.y); y[3] = bfhi(c.y) * bfhi(u.y);
                    y[4] = bflo(c.z) * bflo(u.z); y[5] = bfhi(c.z) * bfhi(u.z); y[6] = bflo(c.w) * bflo(u.w); y[7] = bfhi(c.w) * bfhi(u.w);
#pragma unroll
                    for (int j = 0; j < 8; ++j) z[j] += (d == 0 ? cw2[j] : (d == 1 ? cw1[j] : cw0[j])) * y[j];
                }
            }
            const v4u b = *((const GAS v4u*)(row + CBOFF) + lane);
            float v[8];
            v[0] = bflo(b.x) * z[0]; v[1] = bfhi(b.x) * z[1]; v[2] = bflo(b.y) * z[2]; v[3] = bfhi(b.y) * z[3];
            v[4] = bflo(b.z) * z[4]; v[5] = bfhi(b.z) * z[5]; v[6] = bflo(b.w) * z[6]; v[7] = bfhi(b.w) * z[7];
            float ss = 0.f;
#pragma unroll
            for (int j = 0; j < 8; ++j) ss += v[j] * v[j];
            const float rstd = 1.f / sqrtf(wave_sum(ss) * (1.f / 512.f) + NORM_EPS);
            v4u r; r.x = pk2(v[0] * rstd * gc[0], v[1] * rstd * gc[1]); r.y = pk2(v[2] * rstd * gc[2], v[3] * rstd * gc[3]);
            r.z = pk2(v[4] * rstd * gc[4], v[5] * rstd * gc[5]); r.w = pk2(v[6] * rstd * gc[6], v[7] * rstd * gc[7]);
            *((GAS v4u*)(F.MIX + (size_t)t * DM + 512) + lane) = r;
        }
    }
}
__device__ __forceinline__ float lambda_full(const Frame& F) {
    const int l = F.lane; const float a = wave_sum(F.lq1[l] * F.lk1[l]), b = wave_sum(F.lq2[l] * F.lk2[l]);
    return expf(a) - expf(b) + LAMBDA_INIT;
}
#if NAIVE_ATTN
#define NAIVE_DOT(kr, s0, s1) do { _Pragma("unroll") for (int c_ = 0; c_ < 16; ++c_) { const v4u w_ = *((const GAS v4u*)(kr) + c_); const LAS float* q_ = qs + 8 * c_; \
    const float d_ = q_[0] * bflo(w_.x) + q_[1] * bfhi(w_.x) + q_[2] * bflo(w_.y) + q_[3] * bfhi(w_.y) + q_[4] * bflo(w_.z) + q_[5] * bfhi(w_.z) + q_[6] * bflo(w_.w) + q_[7] * bfhi(w_.w); \
    if (c_ < 8) s0 += d_; else s1 += d_; } } while (0)
__device__ __forceinline__ void p3_attention(Frame& F) {
    const int gw = F.vcu * NWAVES + F.wave, NGW = F.G * NWAVES, lane = F.lane;
    const float lam = lambda_full(F);
    LAS float* qs = (LAS float*)(F.lds + RING_OFF) + F.wave * 256;
    LAS float* af = qs + 128;
    for (int R = gw; R < NBATCH * NHEAD * SEQ; R += NGW) {
        const int bh = R / SEQ, q = R % SEQ, b = bh / NHEAD, h = bh % NHEAD;
        const bf16* base = F.PROJ + (size_t)b * SEQ * INC + h * 128;
        qs[lane] = bf2f(base[(size_t)q * INC + lane]); qs[64 + lane] = bf2f(base[(size_t)q * INC + 64 + lane]);
        LDS_WAIT(); asm volatile("" ::: "memory");
        float m0 = -INFINITY, l0 = 0.f, m1 = -INFINITY, l1 = 0.f;
        for (int j = lane; j <= q; j += 64) {
            const bf16* kr = base + (size_t)j * INC + KOFF; float s0 = 0.f, s1 = 0.f;
            NAIVE_DOT(kr, s0, s1);
            { const float mn = fmaxf(m0, s0); l0 = l0 * exp2f(m0 - mn) + exp2f(s0 - mn); m0 = mn; }
            { const float mn = fmaxf(m1, s1); l1 = l1 * exp2f(m1 - mn) + exp2f(s1 - mn); m1 = mn; }
        }
        const float M0 = wave_max(m0), M1 = wave_max(m1);
        const float L0 = wave_sum(l0 * exp2f(m0 - M0)), L1 = wave_sum(l1 * exp2f(m1 - M1));
        float o0 = 0.f, o1 = 0.f;
        for (int j0 = 0; j0 <= q; j0 += 64) {
            const int j = j0 + lane; float a = 0.f;
            if (j <= q) { const bf16* kr = base + (size_t)j * INC + KOFF; float s0 = 0.f, s1 = 0.f;
                NAIVE_DOT(kr, s0, s1);
                a = exp2f(s0 - M0) / L0 - lam * exp2f(s1 - M1) / L1; }
            af[lane] = a; LDS_WAIT(); asm volatile("" ::: "memory");
            const int nj = (q - j0 + 1) < 64 ? (q - j0 + 1) : 64;
            for (int jj = 0; jj < nj; ++jj) { const unsigned w = *(const unsigned*)(base + (size_t)(j0 + jj) * INC + VOFF + 2 * lane); const float aj = af[jj]; o0 += aj * bflo(w); o1 += aj * bfhi(w); }
            LDS_WAIT(); asm volatile("" ::: "memory");
        }
        const float ss = wave_sum(o0 * o0 + o1 * o1); const float rstd = 1.f / sqrtf(ss * (1.f / 128.f) + NORM_EPS);
        const float g0 = F.g_sub[2 * lane], g1 = F.g_sub[2 * lane + 1];
        *(unsigned*)(F.MIX + (size_t)(b * SEQ + q) * DM + h * 128 + 2 * lane) = pk2(o0 * rstd * g0 * (1.f - LAMBDA_INIT), o1 * rstd * g1 * (1.f - LAMBDA_INIT));
    }
}
#else
namespace att {
constexpr int KT_BYTES = 8192, KSTAGE = 16384, VSTAGE = 16384, VRING = 2 * KSTAGE, VNST = ATT_STAGGER ? 3 : 2, CVSCR = VRING + VNST * VSTAGE, CVBUF = 8 * 4096;
__device__ __forceinline__ s16x4 vtr(const LAS unsigned char* p) { return __builtin_bit_cast(s16x4, __builtin_amdgcn_ds_read_tr16_b64_v4i16((LAS s16x4*)p)); }
}
struct CvPiece { const float* src; unsigned char* dst; int N, K, fp8; float scale; };
constexpr int CV_PER_EXPERT = 192, CV_TOTAL = NE * CV_PER_EXPERT;
__device__ __forceinline__ CvPiece cv_decode(const Frame& F, int sp, int w) {
    const int e = sp / CV_PER_EXPERT; int r = sp - e * CV_PER_EXPERT; CvPiece c;
    if (r < 128) { const int up = r >= 64; r &= 63; const int nb = (r >> 5) * 8 + w, kb = r & 31, n0 = 32 * nb, k0 = 32 * kb;
        c.src = (up ? F.w_up : F.w_gate) + (size_t)e * DM * DFF + (size_t)k0 * DFF + n0; c.N = DFF; c.K = DM;
        c.dst = (unsigned char*)F.Wt_gu + ((size_t)(e * 1024 + (n0 >> 7) * 256 + up * 128 + (n0 & 127)) * DM + k0) * MOE_ESZ; c.fp8 = MOE_FP8; c.scale = WSCALE; }
    else { r -= 128; const int nb = (r >> 4) * 8 + w, kb = r & 15, n0 = 32 * nb, k0 = 32 * kb;
        c.src = F.w_down + (size_t)e * DFF * DM + (size_t)k0 * DM + n0; c.N = DM; c.K = DFF;
        c.dst = (unsigned char*)F.Wt_d + ((size_t)(e * 1024 + n0) * DFF + k0) * DOWN_ESZ; c.fp8 = MOE_FP8_DOWN; c.scale = WSCALE_D; }
    return c;
}
__device__ __forceinline__ void cv_issue(const CvPiece& c, int lane, LAS float* scr) {
    const char* sb = (const char*)c.src; asm volatile("" : "+s"(sb));
#pragma unroll
    for (int i = 0; i < 4; ++i) { const unsigned voff = (unsigned)(((8 * i + (lane >> 3)) * c.N + (((lane & 7) ^ (2 * i)) << 2)) * 4);
        __builtin_amdgcn_global_load_lds((const unsigned*)(sb + voff), (LAS unsigned*)((LAS unsigned char*)scr + i * 1024), 16, 0, 0); }
}
__device__ __forceinline__ void cv_finish(const CvPiece& c, int lane, LAS float* scr) {
#pragma unroll
    for (int j = 0; j < 2; ++j) { const int task = lane + 64 * j, n = task >> 2, cc = task & 3; const LAS float* s = (const LAS float*)((const LAS unsigned char*)scr + (8 * cc) * 128 + (((n >> 2) ^ (2 * cc)) << 4) + (n & 3) * 4);
        if (c.fp8) { const float sc = c.scale; v2u o; o.x = pk4_fp8(s[0 * 32] * sc, s[1 * 32] * sc, s[2 * 32] * sc, s[3 * 32] * sc); o.y = pk4_fp8(s[4 * 32] * sc, s[5 * 32] * sc, s[6 * 32] * sc, s[7 * 32] * sc);
            *(GAS v2u*)(c.dst + (size_t)n * c.K + 8 * cc) = o; }
        else { v4u o; o.x = pk2(s[0 * 32], s[1 * 32]); o.y = pk2(s[2 * 32], s[3 * 32]); o.z = pk2(s[4 * 32], s[5 * 32]); o.w = pk2(s[6 * 32], s[7 * 32]);
            *(GAS v4u*)(c.dst + ((size_t)n * c.K + 8 * cc) * 2) = o; } }
    LDS_WAIT(); asm volatile("" ::: "memory");
}
__device__ __forceinline__ void p3_attention(Frame& F) {
    using namespace att;
    const int tid = F.tid, lane = F.lane, wid = F.wave, r32 = lane & 31, hi = lane >> 5;
    const int map = wid >> 2, wq = wid & 3;
    const float lam = lambda_full(F);
    LAS unsigned char* L = F.lds + RING_OFF;
    const int krow = wid * 8 + (lane >> 3), kch = (lane & 7) ^ ((krow >> 1) & 7);
    const int vrow0 = wid * 4 + (lane >> 4), vrow1 = vrow0 + 32;
    const int vch0 = (lane & 15) ^ (((vrow0 & 3) << 2) | ((vrow0 >> 2) & 3)), vch1 = (lane & 15) ^ (((vrow1 & 3) << 2) | ((vrow1 >> 2) & 3));
    const unsigned kvoff = (unsigned)((krow * INC + KOFF + kch * 8) * 2), vvoff0 = (unsigned)((vrow0 * INC + VOFF + vch0 * 8) * 2);
    (void)vrow1; (void)vch1;
    const unsigned ksw = (unsigned)((r32 >> 1) & 7), kb0 = (unsigned)(map * KT_BYTES + r32 * 128) + (((unsigned)hi ^ (ksw & 1u)) << 4), ks6 = (ksw & 6u) << 4;
#define KFRAG_OFF(d0) (kb0 + ((32u * (d0)) ^ ks6))
    const int vq = (lane & 15) >> 2, vp = lane & 3, vblk = (lane >> 4) & 1;
    unsigned vlow[2];
#pragma unroll
    for (int t = 0; t < 2; ++t) vlow[t] = (unsigned)(256 * (8 * t + 4 * hi + vq) + 16 * ((2 * vblk + (vp >> 1)) ^ ((2 * t + hi) & 3)) + 8 * (vp & 1));
    const unsigned vq6 = (unsigned)vq << 6;
#define VCX(c) ((64u * (c)) ^ vq6)

    LAS float* cvscr = (LAS float*)(L + CVSCR) + wid * 1024;
    static_assert(CVSCR + 2 * CVBUF <= RING_BYTES, "attention LDS map");
    int cvp, cvend; { const int per = (CV_TOTAL + F.G - 1) / F.G; cvp = F.vcu * per; cvend = cvp + per < CV_TOTAL ? cvp + per : CV_TOTAL; if (cvp > cvend) cvp = cvend; }
    CvPiece cvq; bool havep = false; int cvb = 0;
#pragma unroll 1
    for (int rep_ = 0; rep_ < 1 + DUP(3); ++rep_)
    for (int pr = F.vcu; pr < 256; pr += F.G) {
      const int bh = pr >> 3, b = bh >> 2, h = bh & 3, s8 = pr & 7;
#pragma unroll 1
      for (int half = 0; half < 2; ++half) {
        const int qb = half ? 15 - s8 : s8;
        const int NT = 2 * (qb + 1);
        const int q0w = qb * 128 + wq * 32;
        const bf16* Pb = F.PROJ + (size_t)b * SEQ * INC + h * 128;
        bf16x8 qf[4];
        unsigned qvoff_now; { int r32q = r32, hiq = hi; asm volatile("" : "+v"(r32q), "+v"(hiq)); qvoff_now = (unsigned)((r32q * INC + hiq * 8) * 2); }
#pragma unroll
        for (int d0 = 0; d0 < 4; ++d0) qf[d0] = *(const bf16x8*)((const char*)Pb + ((size_t)q0w * INC + map * 64 + d0 * 16) * 2 + qvoff_now);
        f32x16 o[4];
#pragma unroll
        for (int c = 0; c < 4; ++c)
#pragma unroll
            for (int r = 0; r < 16; ++r) o[c][r] = 0.f;
        float mrow = -INFINITY, lrow = 0.f;
        const char* Pbc = (const char*)Pb;
#define ATT_DMA(t, ks, vs) do { const char* tb_ = Pbc + (size_t)(t) * 64 * INC * 2; asm volatile("" : "+s"(tb_)); LAS unsigned char* kb_ = L + (ks) * KSTAGE; LAS unsigned char* vb_ = L + VRING + (vs) * VSTAGE;   \
        __builtin_amdgcn_global_load_lds((const unsigned*)(tb_ + kvoff), (LAS unsigned*)(kb_ + wid * 1024), 16, 0, 0); \
        __builtin_amdgcn_global_load_lds((const unsigned*)(tb_ + 128 + kvoff), (LAS unsigned*)(kb_ + KT_BYTES + wid * 1024), 16, 0, 0); \
        __builtin_amdgcn_global_load_lds((const unsigned*)(tb_ + vvoff0), (LAS unsigned*)(vb_ + wid * 1024), 16, 0, 0); \
        __builtin_amdgcn_global_load_lds((const unsigned*)(tb_ + 32 * INC * 2 + vvoff0), (LAS unsigned*)(vb_ + 8192 + wid * 1024), 16, 0, 0); } while (0)
#define ATT_STEP_BAR() do { asm volatile("s_waitcnt lgkmcnt(0)" ::: "memory"); __builtin_amdgcn_s_barrier(); asm volatile("" ::: "memory"); } while (0)
#define ATT_QKSM1(kfb, kvb) do { f32x16 p; \
            _Pragma("unroll") for (int r = 0; r < 16; ++r) p[r] = 0.f; \
            _Pragma("unroll") for (int d0 = 0; d0 < 4; ++d0) { const bf16x8 kf = *(const LAS bf16x8*)((kfb) + KFRAG_OFF(d0)); p = __builtin_amdgcn_mfma_f32_32x32x16_bf16(kf, qf[d0], p, 0, 0, 0); } \
            if ((kvb) + 31 > q0w) { asm volatile("" ::: "memory"); const int qabs = q0w + r32; \
                _Pragma("unroll") for (int r = 0; r < 16; ++r) { const int kv = (kvb) + (r & 3) + 8 * (r >> 2) + 4 * hi; if (kv > qabs) p[r] = -INFINITY; } } \
            float rm = p[0]; \
            _Pragma("unroll") for (int r = 1; r < 16; ++r) rm = fmaxf(rm, p[r]); \
            rm = fmaxf(rm, __shfl_xor(rm, 32)); \
            const float mnew = fmaxf(mrow, rm); const float alpha = __builtin_amdgcn_exp2f(mrow - mnew); mrow = mnew; \
            float ls = 0.f; \
            _Pragma("unroll") for (int r = 0; r < 16; ++r) { const float e = __builtin_amdgcn_exp2f(p[r] - mnew); p[r] = e; ls += e; } \
            lrow = lrow * alpha + ls; \
            if (__any(alpha != 1.0f)) { _Pragma("unroll") for (int c = 0; c < 4; ++c) _Pragma("unroll") for (int r = 0; r < 16; ++r) o[c][r] *= alpha; } \
            _Pragma("unroll") for (int s = 0; s < 2; ++s) { v4u pw; pw.x = pk2(p[8 * s + 0], p[8 * s + 1]); pw.y = pk2(p[8 * s + 2], p[8 * s + 3]); \
                pw.z = pk2(p[8 * s + 4], p[8 * s + 5]); pw.w = pk2(p[8 * s + 6], p[8 * s + 7]); pf2[s] = pw; } } while (0)
#define ATT_VLD(dst, vrb, s) do { const LAS unsigned char* vb_ = (vrb) + 256 * (16 * (s)); _Pragma("unroll") for (int c = 0; c < 4; ++c) { const s16x4 lo = vtr(vb_ + (vlow[0] + VCX(c))), hh = vtr(vb_ + (vlow[1] + VCX(c))); \
            dst[c] = (bf16x8){lo[0], lo[1], lo[2], lo[3], hh[0], hh[1], hh[2], hh[3]}; } } while (0)
#define ATT_VMM(src, s) do { const bf16x8 pfr = __builtin_bit_cast(bf16x8, pf2[s]); _Pragma("unroll") for (int c = 0; c < 4; ++c) o[c] = __builtin_amdgcn_mfma_f32_32x32x16_bf16(src[c], pfr, o[c], 0, 0, 0); } while (0)
#define ATT_PV1(vrb) do { bf16x8 va_[4], vb2_[4]; __builtin_amdgcn_sched_barrier(0); ATT_VLD(va_, vrb, 0); __builtin_amdgcn_sched_barrier(0); \
            ATT_VLD(vb2_, vrb, 1); ATT_VMM(va_, 0); __builtin_amdgcn_sched_barrier(0); ATT_VMM(vb2_, 1); __builtin_amdgcn_sched_barrier(0); } while (0)
        ATT_DMA(0, 0, 0);
        asm volatile("s_waitcnt vmcnt(0)" ::: "memory");
        ATT_STEP_BAR();
        v4u pf2[2]; bool pend = false;
        int kst = 0, vst = 0, vst_prev = VNST - 1;
#pragma unroll 1
        for (int t = 0; t < NT; ++t) {
            const int vst_next = vst == VNST - 1 ? 0 : vst + 1;
            if (t + 1 < NT) ATT_DMA(t + 1, kst ^ 1, vst_next);
            CvPiece cvn; const bool issued = cvp < cvend;
            if (issued) { cvn = cv_decode(F, cvp, wid); cv_issue(cvn, lane, (LAS float*)((LAS unsigned char*)cvscr + cvb * CVBUF)); }
            const int kv0 = t * 64;
            const LAS unsigned char* ksb = L + kst * KSTAGE; const LAS unsigned char* vcur = L + VRING + vst * VSTAGE; const LAS unsigned char* vprv = L + VRING + vst_prev * VSTAGE;
#pragma unroll
            for (int kb = 0; kb < 2; ++kb) {
                const bool act = kv0 + 32 * kb <= q0w + 31;
                if (map == 0 || !ATT_STAGGER) { if (act) { ATT_QKSM1(ksb + kb * 4096, kv0 + 32 * kb); ATT_PV1(vcur + kb * 8192); } }
                else { if (pend) { if (kb == 0) { ATT_PV1(vprv + 8192); } else { ATT_PV1(vcur); } } if (act) { ATT_QKSM1(ksb + kb * 4096, kv0 + 32 * kb); } pend = act; }
            }
            if (issued) asm volatile("s_waitcnt vmcnt(4)" ::: "memory"); else asm volatile("s_waitcnt vmcnt(0)" ::: "memory");
            if (havep) cv_finish(cvq, lane, (LAS float*)((LAS unsigned char*)cvscr + (cvb ^ 1) * CVBUF));
            havep = issued; if (issued) { cvq = cvn; cvb ^= 1; ++cvp; }
            ATT_STEP_BAR();
            kst ^= 1; vst_prev = vst; vst = vst_next;
        }
        if (ATT_STAGGER && map == 1 && pend) { ATT_PV1(L + VRING + vst_prev * VSTAGE + 8192); }
        __syncthreads();
#undef ATT_DMA
#undef ATT_STEP_BAR
#undef ATT_QKSM1
#undef ATT_PV1
#undef ATT_VLD
#undef ATT_VMM
        lrow += __shfl_xor(lrow, 32);
        const float inv = 1.0f / lrow;
        int lanee = lane; asm volatile("" : "+v"(lanee));
        LAS float* xb = (LAS float*)L + wq * 4096 + lanee;
        if (map == 1) {
#pragma unroll
            for (int c = 0; c < 4; ++c)
#pragma unroll
                for (int r = 0; r < 16; ++r) xb[(c * 16 + r) * 64] = o[c][r] * inv;
        }
        __syncthreads();
        if (map == 0) {
            int r32e = r32, hie = hi; asm volatile("" : "+v"(r32e), "+v"(hie));
            float ss = 0.f;
#pragma unroll
            for (int c = 0; c < 4; ++c)
#pragma unroll
                for (int r = 0; r < 16; ++r) { const float v = o[c][r] * inv - lam * xb[(c * 16 + r) * 64]; o[c][r] = v; ss += v * v; }
            ss += __shfl_xor(ss, 32);
            const float rstd = (1.f - LAMBDA_INIT) / sqrtf(ss * (1.f / 128.f) + NORM_EPS);
            bf16* orow = F.MIX + (size_t)(b * SEQ + q0w + r32e) * DM + h * 128 + 4 * hie;
#pragma unroll
            for (int c = 0; c < 4; ++c)
#pragma unroll
                for (int g = 0; g < 4; ++g) { const int dv = 32 * c + 8 * g + 4 * hie; const f32x4 gn = *(const f32x4*)(F.g_sub + dv);
                    v2u w; w.x = pk2(o[c][4 * g + 0] * rstd * gn[0], o[c][4 * g + 1] * rstd * gn[1]); w.y = pk2(o[c][4 * g + 2] * rstd * gn[2], o[c][4 * g + 3] * rstd * gn[3]);
                    *(GAS v2u*)(orow + 32 * c + 8 * g) = w; }
        }
        __syncthreads();
      }
    }
    if (havep) { asm volatile("s_waitcnt vmcnt(0)" ::: "memory"); cv_finish(cvq, lane, (LAS float*)((LAS unsigned char*)cvscr + (cvb ^ 1) * CVBUF)); }
#pragma unroll 1
    for (; cvp < cvend; ++cvp) { const CvPiece c = cv_decode(F, cvp, wid); cv_issue(c, lane, cvscr); asm volatile("s_waitcnt vmcnt(0)" ::: "memory"); cv_finish(c, lane, cvscr); }
}
#endif
__device__ __forceinline__ void p5_router(Frame& F) {
    const int lane = F.lane, tid = F.tid, fr = lane & 15, fq = lane >> 4;
    LAS float* LG = (LAS float*)(F.lds + RING_OFF);
    LAS float* SS = LG + 2 * 64 * 48;
    LAS int* cpart = (LAS int*)(SS + 128);
    LAS int* se = cpart + 64;
    const int tt = F.wave & 3, kh = F.wave >> 2;
    for (int c = F.vcu; c < NTOK / 64; c += F.G) {
        {
            const bf16* hrow = F.H + (size_t)(c * 64 + tt * 16 + fr) * DM + kh * 512 + fq * 8;
            const float* grow = F.g_ffn + kh * 512 + fq * 8; unsigned char* orow = (unsigned char*)F.HN2 + ((size_t)(c * 64 + tt * 16 + fr) * DM + kh * 512 + fq * 8) * MOE_ESZ;
            const bf16* wh = F.Wr_hi + (size_t)fr * DM + kh * 512 + fq * 8; const bf16* wl = F.Wr_lo + (size_t)fr * DM + kh * 512 + fq * 8;
            f32x4 acc[3]; acc[0] = acc[1] = acc[2] = (f32x4){0.f, 0.f, 0.f, 0.f};
            float ss = 0.f;
#pragma unroll 4
            for (int s = 0; s < 16; ++s) {
                const v4u hw = *(const GAS v4u*)(hrow + 32 * s);
                const f32x4 a0 = (f32x4){bflo(hw.x), bfhi(hw.x), bflo(hw.y), bfhi(hw.y)}, a1 = (f32x4){bflo(hw.z), bfhi(hw.z), bflo(hw.w), bfhi(hw.w)};
                { const f32x4 g0 = *(const GAS f32x4*)(grow + 32 * s), g1 = *(const GAS f32x4*)(grow + 32 * s + 4);
#if MOE_FP8
                  v2u hv; hv.x = pk4_fp8(a0.x * g0.x * XSCALE, a0.y * g0.y * XSCALE, a0.z * g0.z * XSCALE, a0.w * g0.w * XSCALE); hv.y = pk4_fp8(a1.x * g1.x * XSCALE, a1.y * g1.y * XSCALE, a1.z * g1.z * XSCALE, a1.w * g1.w * XSCALE);
                  *(GAS v2u*)((unsigned char*)orow + 32 * s) = hv; }
#else
                  v4u hv; hv.x = pk2(a0.x * g0.x, a0.y * g0.y); hv.y = pk2(a0.z * g0.z, a0.w * g0.w); hv.z = pk2(a1.x * g1.x, a1.y * g1.y); hv.w = pk2(a1.z * g1.z, a1.w * g1.w);
                  *(GAS v4u*)((unsigned char*)orow + 64 * s) = hv; }
#endif
                ss += (a0.x * a0.x + a0.y * a0.y) + (a0.z * a0.z + a0.w * a0.w) + (a1.x * a1.x + a1.y * a1.y) + (a1.z * a1.z + a1.w * a1.w);
                const bf16x8 ah = __builtin_bit_cast(bf16x8, hw);
#pragma unroll
                for (int ct = 0; ct < 3; ++ct) {
                    const bf16x8 bh = *(const GAS bf16x8*)(wh + (size_t)ct * 16 * DM + 32 * s), bl = *(const GAS bf16x8*)(wl + (size_t)ct * 16 * DM + 32 * s);
                    acc[ct] = __builtin_amdgcn_mfma_f32_16x16x32_bf16(ah, bh, acc[ct], 0, 0, 0);
                    acc[ct] = __builtin_amdgcn_mfma_f32_16x16x32_bf16(ah, bl, acc[ct], 0, 0, 0);
                }
            }
            ss += __shfl_xor(ss, 16); ss += __shfl_xor(ss, 32);
            if (fq == 0) SS[kh * 64 + tt * 16 + fr] = ss;
#pragma unroll
            for (int ct = 0; ct < 3; ++ct)
#pragma unroll
                for (int r = 0; r < 4; ++r) LG[(kh * 64 + tt * 16 + 4 * fq + r) * 48 + ct * 16 + fr] = acc[ct][r];
        }
        __syncthreads();
        if (tid < 64) {
            const int t = c * 64 + tid;
            const float rstd = 1.f / sqrtf((SS[tid] + SS[64 + tid]) * (1.f / DM) + NORM_EPS);
            const LAS float* l0 = LG + tid * 48; const LAS float* l1 = LG + (64 + tid) * 48;
            float g4[4];
#pragma unroll
            for (int a = 0; a < 4; ++a) g4[a] = (l0[a] + l1[a]) * rstd;
            int gs = 0; float gm = g4[0];
#pragma unroll
            for (int a = 1; a < 4; ++a) if (g4[a] > gm) { gm = g4[a]; gs = a; }
            float den = 0.f;
#pragma unroll
            for (int a = 0; a < 4; ++a) den += expf(g4[a] - gm);
            const float ggate = 1.f / den;
            float el[8];
#pragma unroll
            for (int a = 0; a < 8; ++a) el[a] = (l0[4 + gs * 8 + a] + l1[4 + gs * 8 + a]) * rstd;
            int i1 = 0; float v1 = el[0];
#pragma unroll
            for (int a = 1; a < 8; ++a) if (el[a] > v1) { v1 = el[a]; i1 = a; }
            int i2 = -1; float v2 = -INFINITY;
#pragma unroll
            for (int a = 0; a < 8; ++a) if (a != i1 && el[a] > v2) { v2 = el[a]; i2 = a; }
            const float d = expf(v2 - v1), w1 = ggate / (1.f + d), w2 = ggate * d / (1.f + d);
            F.tok_e[2 * t] = gs * 8 + i1; F.tok_e[2 * t + 1] = gs * 8 + i2; F.tok_w[2 * t] = w1; F.tok_w[2 * t + 1] = w2; se[2 * tid] = gs * 8 + i1; se[2 * tid + 1] = gs * 8 + i2;
            F.tok_rs[t] = rstd;
        }
        __syncthreads();
        if (tid < 128) { const int myE = se[tid]; int mycnt = 0;
#pragma unroll 4
            for (int e = 0; e < NE; ++e) { const unsigned long long mk = __ballot(myE == e); if (lane == e) mycnt = __popcll(mk); }
            if (lane < NE) cpart[F.wave * NE + lane] = mycnt; }
        __syncthreads();
        if (tid < NE) F.ccnt[c * NE + tid] = cpart[tid] + cpart[NE + tid];
        __syncthreads();
    }
}
__device__ __forceinline__ void p6_slots(Frame& F) {
    const int tid = F.tid, lane = F.lane;
    LAS int* part = (LAS int*)(F.lds + RING_OFF);
    LAS int* cnt = part + 512;
    LAS int* pstart = cnt + 32;
    LAS int* pref = pstart + 32;
    LAS int* se = pref + 32;
    LAS int* dst = se + 128;
    LAS int* w0cnt = dst + 128;
    LAS int* tab = (LAS int*)(F.lds + TAB_OFF);
    { const int e = tid & 31, p = tid >> 5; int s = 0; for (int c = p * 16; c < p * 16 + 16; ++c) s += F.ccnt[c * NE + e]; part[p * 32 + e] = s; }
    __syncthreads();
    if (tid < NE) { int s = 0; for (int p = 0; p < 16; ++p) s += part[p * 32 + tid]; cnt[tid] = s; }
    __syncthreads();
    if (tid == 0) { int acc = 0; for (int e = 0; e < NE; ++e) { pstart[e] = acc; const int nt = (cnt[e] + 255) >> 8; for (int i = 0; i < nt; ++i) tab[1 + (acc >> 8) + i] = e; acc += nt << 8; } tab[0] = acc >> 8; }
    __syncthreads();
    if (blockIdx.x == 0) { const int nT = tab[0]; for (int i = tid; i <= nT; i += NWAVES * 64) F.ttab[i] = tab[i]; }
    for (int c = F.vcu; c < NTOK / 64; c += F.G) {
        { const int e = tid & 31, p = tid >> 5; int s = 0; for (int cc = p * 16; cc < p * 16 + 16; ++cc) if (cc < c) s += F.ccnt[cc * NE + e]; part[p * 32 + e] = s; }
        if (tid < 128) se[tid] = F.tok_e[c * 128 + tid];
        __syncthreads();
        if (tid < NE) { int s = 0; for (int p = 0; p < 16; ++p) s += part[p * 32 + tid]; pref[tid] = s; }
        __syncthreads();
        int myrank = 0;
        if (tid < 128) { const int e = se[tid]; const unsigned long long below = (1ull << lane) - 1ull;
#pragma unroll 4
            for (int ee = 0; ee < NE; ++ee) { const unsigned long long mk = __ballot(e == ee); if (e == ee) myrank = __popcll(mk & below); if (F.wave == 0 && lane == ee) w0cnt[ee] = __popcll(mk); } }
        __syncthreads();
        if (tid < 128) { const int e = se[tid]; const int r = myrank + (F.wave == 1 ? w0cnt[e] : 0);
            const int d = pstart[e] + pref[e] + r; F.slot_tok[d] = c * 128 + tid; F.slot_w[d] = F.tok_w[c * 128 + tid]; F.slot_rs[d] = F.tok_rs[c * 64 + (tid >> 1)]; }
        __syncthreads();
    }
}
__device__ __forceinline__ int load_tile_table(Frame& F) {
    LAS int* tab = (LAS int*)(F.lds + TAB_OFF);
    int nT = F.ttab[0]; nT = nT < 0 ? 0 : (nT > MAXT ? MAXT : nT);
    for (int i = F.tid; i <= nT; i += NWAVES * 64) tab[i] = F.ttab[i];
    __syncthreads();
    return __builtin_amdgcn_readfirstlane(nT);
}
template <bool DUMMY> __device__ __forceinline__ void p9_combine(Frame& F) {
    const int gw = F.vcu * NWAVES + F.wave, NGW = F.G * NWAVES, lane = F.lane;
    for (int t = gw; t < NTOK; t += NGW) {
        GAS f32x4* orow = (GAS f32x4*)(F.out + (size_t)t * DM); GAS f32x4* wrow = DUMMY ? (GAS f32x4*)((float*)F.ACT + (size_t)(t & 2047) * DM) : orow;
        const GAS v4u* y0 = (const GAS v4u*)(F.Y2 + (size_t)(2 * t) * DM); const GAS v4u* y1 = (const GAS v4u*)(F.Y2 + (size_t)(2 * t + 1) * DM); const GAS v4u* hr = (const GAS v4u*)(F.H + (size_t)t * DM);
        v4u a[2], b[2], h[2];
#pragma unroll
        for (int j = 0; j < 2; ++j) { const int ch = lane + 64 * j; a[j] = y0[ch]; b[j] = y1[ch]; h[j] = hr[ch]; }
        asm volatile("s_waitcnt vmcnt(0)" ::: "memory");
#pragma unroll
        for (int j = 0; j < 2; ++j) { const int ch = lane + 64 * j; f32x4 h0, h1;
            h0.x = bflo(h[j].x) + bflo(a[j].x) + bflo(b[j].x); h0.y = bfhi(h[j].x) + bfhi(a[j].x) + bfhi(b[j].x); h0.z = bflo(h[j].y) + bflo(a[j].y) + bflo(b[j].y); h0.w = bfhi(h[j].y) + bfhi(a[j].y) + bfhi(b[j].y);
            h1.x = bflo(h[j].z) + bflo(a[j].z) + bflo(b[j].z); h1.y = bfhi(h[j].z) + bfhi(a[j].z) + bfhi(b[j].z); h1.z = bflo(h[j].w) + bflo(a[j].w) + bflo(b[j].w); h1.w = bfhi(h[j].w) + bfhi(a[j].w) + bfhi(b[j].w);
            wrow[2 * ch] = h0; wrow[2 * ch + 1] = h1; }
    }
}
struct Args { const void* in[20]; float* out; unsigned char* ws; int ph_lo, ph_hi, li, pad; };
#if SIMPLE_GEMM
#define RUN_GEMM(EpiT, SchedT, ALIGN, g, S, E) pg8::simple_gemm_phase<EpiT, SchedT>(g, S, E)
#else
#define RUN_GEMM(EpiT, SchedT, ALIGN, g, S, E) pg8::gemm_phase<EpiT, SchedT, ALIGN, true>(F.lds + RING_OFF, g, S, E, F.wave)
#endif
#define RUN_GEMM_X(EpiT, SchedT, ALIGN, GATHER, G64, g, S, E) pg8::gemm_phase<EpiT, SchedT, ALIGN, true, GATHER, G64>(F.lds + RING_OFF, g, S, E, F.wave)
__device__ __forceinline__ int hw_lane_fresh() { int l; asm volatile("v_mbcnt_lo_u32_b32 %0, -1, 0\n\tv_mbcnt_hi_u32_b32 %0, -1, %0" : "=v"(l)); return l; }
__global__ void __launch_bounds__(NWAVES * 64, 2) fwd(Args args) {
    extern __shared__ __attribute__((aligned(16))) unsigned char lds[];
    Frame F;
    F.lds = (LAS unsigned char*)lds;
    F.MISC = (volatile LAS unsigned*)(F.lds + MISC_OFF);
    F.tid = threadIdx.x; F.lane = F.tid & 63; F.wave = __builtin_amdgcn_readfirstlane(F.tid >> 6);
    F.G = gridDim.x; { const int bx = blockIdx.x; F.vcu = (F.G % 8 == 0) ? (bx % 8) * (F.G / 8) + bx / 8 : bx; }
    unsigned char* ws = args.ws;
    F.ctl = (gu32*)(ws + WS_CTL);
    F.x = (const float*)args.in[0]; F.pos = (const int*)args.in[1]; F.g_attn = (const float*)args.in[2]; F.w_in = (const float*)args.in[3];
    F.g_q = (const float*)args.in[4]; F.g_k = (const float*)args.in[5]; F.lq1 = (const float*)args.in[6]; F.lk1 = (const float*)args.in[7];
    F.lq2 = (const float*)args.in[8]; F.lk2 = (const float*)args.in[9]; F.g_sub = (const float*)args.in[10]; F.conv_w = (const float*)args.in[11];
    F.g_conv = (const float*)args.in[12]; F.w_out = (const float*)args.in[13]; F.g_ffn = (const float*)args.in[14]; F.w_gr = (const float*)args.in[15];
    F.w_er = (const float*)args.in[16]; F.w_gate = (const float*)args.in[17]; F.w_up = (const float*)args.in[18]; F.w_down = (const float*)args.in[19];
    F.out = args.out;
    F.Wt_in = (bf16*)(ws + WS_WIN); F.Wt_out = (bf16*)(ws + WS_WOUT); F.Wt_gu = (bf16*)(ws + WS_WGU); F.Wt_d = (bf16*)(ws + WS_WD);
    F.HN = (bf16*)args.out;
    F.PROJ = (bf16*)(ws + WS_PROJ); F.MIX = (bf16*)(ws + WS_MIX); F.HN2 = (bf16*)(ws + WS_HN2); F.ACT = (bf16*)(ws + WS_ACT); F.Y2 = (bf16*)args.out; F.H = (bf16*)(ws + WS_H);
    F.tok_e = (int*)(ws + WS_SMALL + SM_TOKE); F.tok_w = (float*)(ws + WS_SMALL + SM_TOKW); F.slot_tok = (int*)(ws + WS_SMALL + SM_SLOTT); F.slot_w = (float*)(ws + WS_SMALL + SM_SLOTW);
    F.ccnt = (int*)(ws + WS_SMALL + SM_CCNT); F.ttab = (int*)(ws + WS_SMALL + SM_TTAB); F.Wr_hi = (bf16*)(ws + WS_SMALL + SM_WRH); F.Wr_lo = (bf16*)(ws + WS_SMALL + SM_WRL); F.tok_rs = (float*)(ws + WS_SMALL + SM_TOKRS); F.slot_rs = (float*)(ws + WS_SMALL + SM_SLOTRS); F.cs = (float*)(ws + WS_CS);
    for (int u = F.tid; u < (LDS_BYTES - LDSCTL_OFF) / 4; u += NWAVES * 64) ((LAS unsigned*)(F.lds + LDSCTL_OFF))[u] = 0u;
    __syncthreads();
    XcdBarrier bar; bar.bar = (unsigned*)(F.ctl + CW_BAR); bar.x = 0; bar.st = nullptr;
    if (N_LAUNCHES == 1) bar = xcd_barrier_post((unsigned*)(F.ctl + CW_BAR), F.MISC + 8);
#define HW_LANE() hw_lane_fresh()
#define GRID_BAR() do { if (N_LAUNCHES == 1) xcd_barrier(bar, F.wave == 0 && HW_LANE() == 0); } while (0)
    const int lo = args.ph_lo, hi = args.ph_hi;
#define IN(k) (lo <= (k) && (k) < hi)
#define BOTH(k) (IN(k) && IN((k) + 1))

#define PH0() do { p0_prologue(F); } while (0)
#define PH1() do { pg8::Gemm g{F.HN, F.Wt_in, NTOK, INC, DM}; pg8::StaticOrder S; S.init(NTOK, INC, F.G, (int)blockIdx.x); pg8::EpiProjQK E{F.PROJ, INC, F.g_q, F.g_k, F.cs, QSCALE, NORM_EPS}; \
        RUN_GEMM_X(pg8::EpiProjQK, pg8::StaticOrder, true, false, true, g, S, E); } while (0)
#define PH3() do { p2_conv(F); if (DUP(2)) p2_conv(F); p3_attention(F); } while (0)
#define PH4() do { pg8::Gemm g{F.MIX, F.Wt_out, NTOK, DM, DM}; pg8::StaticOrder S; S.init(NTOK, DM, F.G, (int)blockIdx.x); pg8::EpiResidualBf16 E{F.x, F.H, DM}; \
        RUN_GEMM(pg8::EpiResidualBf16, pg8::StaticOrder, true, g, S, E); } while (0)
#define PH5() do { p5_router(F); } while (0)
#define PH6() do { p6_slots(F); } while (0)
#define PH7() do { const int nT = load_tile_table(F); pg8::MoeOrder S; S.init((const LAS int*)(F.lds + TAB_OFF) + 1, nT, F.G, (int)blockIdx.x); \
        LAS unsigned* lists = (LAS unsigned*)(F.lds + LIST_OFF); \
        { pg8::Unit u_; for (int i_ = 0; i_ < MAXLIST && S.next(i_, u_); ++i_) if (F.tid < 256) { const int tk_ = F.slot_tok[u_.pm * 256 + F.tid]; lists[i_ * 256 + F.tid] = tk_ >= 0 ? (unsigned)(tk_ >> 1) * (unsigned)(DM * MOE_ESZ) : 0u; } } \
        __syncthreads(); \
        pg8::Gemm g{F.HN2, F.Wt_gu, NTOK, NE * 1024, DM * MOE_ESZ / 2, lists}; pg8::EpiSwiglu<MOE_FP8_DOWN != 0> E{(void*)F.ACT, F.slot_rs, 1.0f / (XSCALE * WSCALE)}; \
        pg8::gemm_phase<pg8::EpiSwiglu<MOE_FP8_DOWN != 0>, pg8::MoeOrder, true, true, true, false, MOE_FP8 != 0>(F.lds + RING_OFF, g, S, E, F.wave); } while (0)
#if MOE_FP8_DOWN
#define PH8() do { const int nT = load_tile_table(F); pg8::MoeOrder S; S.init((const LAS int*)(F.lds + TAB_OFF) + 1, nT, F.G, (int)blockIdx.x); \
        LAS unsigned* lists = (LAS unsigned*)(F.lds + LIST_OFF); \
        { pg8::Unit u_; for (int i_ = 0; i_ < MAXLIST && S.next(i_, u_); ++i_) if (F.tid < 256) lists[i_ * 256 + F.tid] = (unsigned)(u_.pm * 256 + F.tid) * (unsigned)(DFF * DOWN_ESZ); } \
        __syncthreads(); \
        pg8::Gemm g{F.ACT, F.Wt_d, MAXSLOT, NE * 1024, DFF * DOWN_ESZ / 2, lists}; pg8::EpiDown E{F.Y2, F.slot_tok, F.slot_w, 1.0f / WSCALE_D}; \
        pg8::gemm_phase<pg8::EpiDown, pg8::MoeOrder, P8_ALIGN, true, true, false, true>(F.lds + RING_OFF, g, S, E, F.wave); } while (0)
#else
#define PH8() do { const int nT = load_tile_table(F); pg8::Gemm g{F.ACT, F.Wt_d, MAXSLOT, NE * 1024, DFF * DOWN_ESZ / 2}; pg8::MoeOrder S; S.init((const LAS int*)(F.lds + TAB_OFF) + 1, nT, F.G, (int)blockIdx.x); \
        pg8::EpiDown E{F.Y2, F.slot_tok, F.slot_w, 1.0f / WSCALE_D}; \
        pg8::gemm_phase<pg8::EpiDown, pg8::MoeOrder, P8_ALIGN, true, false, false, false>(F.lds + RING_OFF, g, S, E, F.wave); } while (0)
#endif
#define PH9() do { if (DUP(9)) { p9_combine<true>(F); __syncthreads(); } p9_combine<false>(F); } while (0)
#define REFRESH() do { const int l_ = HW_LANE(); F.lane = l_; F.tid = F.wave * 64 + l_; } while (0)
#define PHASE(k, BODY) if (IN(k)) { REFRESH(); BODY(); if (DUP(k) && (k) != 3) { __syncthreads(); BODY(); } if (BOTH(k)) { GRID_BAR(); if ((k) == 4) for (int xb_ = 0; xb_ < PROBE_XBAR; ++xb_) GRID_BAR(); } }
    PHASE(0, PH0) PHASE(1, PH1) PHASE(3, PH3) PHASE(4, PH4) PHASE(5, PH5) PHASE(6, PH6) PHASE(7, PH7) PHASE(8, PH8)
    if (IN(9)) { REFRESH(); PH9(); }
#undef IN
#undef BOTH
}

extern "C" void kernel_launch(void* const* d_in, const int* in_sizes, int n_in, void* d_out, int out_size, void* d_ws, size_t ws_size, hipStream_t stream) {
    static int grid = 0;
    if (grid == 0) {
        if (n_in != 20 || in_sizes[0] != NTOK * DM || out_size != NTOK * DM || ws_size < WS_END) { fprintf(stderr, "kernel_launch: unexpected shapes (n_in %d, in0 %d, out %d, ws %zu); nothing launched\n", n_in, n_in > 0 ? in_sizes[0] : -1, out_size, ws_size); grid = -1; return; }
        int dev = 0, cus = 0, per_cu = 0;
        if (hipGetDevice(&dev) != hipSuccess || hipDeviceGetAttribute(&cus, hipDeviceAttributeMultiprocessorCount, dev) != hipSuccess) { grid = -1; return; }
        if (hipFuncSetAttribute((const void*)fwd, hipFuncAttributeMaxDynamicSharedMemorySize, LDS_BYTES) != hipSuccess) { fprintf(stderr, "kernel_launch: hipFuncSetAttribute failed\n"); grid = -1; return; }
        if (hipOccupancyMaxActiveBlocksPerMultiprocessor(&per_cu, (const void*)fwd, NWAVES * 64, LDS_BYTES) != hipSuccess || per_cu < 1) { fprintf(stderr, "kernel_launch: occupancy query reports %d workgroups per CU\n", per_cu); per_cu = 1; }
        (void)hipGetLastError();
        grid = cus;
    }
    if (grid < 0) return;
    if (hipMemsetAsync((char*)d_ws + WS_CTL, 0, CTL_ZERO_BYTES, stream) != hipSuccess) return;
    Args a{};
    for (int i = 0; i < 20; ++i) a.in[i] = d_in[i];
    a.out = (float*)d_out; a.ws = (unsigned char*)d_ws;
    if (N_LAUNCHES == 1) { a.ph_lo = 0; a.ph_hi = PER_PHASE; a.li = 0; hipLaunchKernelGGL(fwd, dim3(grid), dim3(NWAVES * 64), LDS_BYTES, stream, a); }
    else for (int li = 0; li < PER_PHASE; ++li) { a.ph_lo = li; a.ph_hi = li + 1; a.li = li; hipLaunchKernelGGL(fwd, dim3(grid), dim3(NWAVES * 64), LDS_BYTES, stream, a); }
}
```
